# Optimizing an MI355X kernel written in HIP

```python
import math
import jax, jax.numpy as jnp
from jax import lax
import numpy as np

D_MODEL = 1024
BATCH = 4
SEQ = 4096
DEPTH = 2
DEC_BATCH = 8
DEC_SEQ = 8192
PAST_LEN = 128

N_EVEN = (DEPTH + 1) // 2
N_ODD = DEPTH // 2
SSM_WIDTH = D_MODEL // 2
SSM_GROUP = 16
SSM_GROUPS = SSM_WIDTH // SSM_GROUP
SSM_STATE = 64
DT_MIN = 1e-3
DT_MAX = 1e-1
GM_WIDTH = D_MODEL // 2
GM_HEADS = 4
GM_HEAD_DIM = GM_WIDTH // GM_HEADS
GM_CHUNK = 128
EVEN_IN = SSM_WIDTH + 2 * GM_WIDTH
HEAD_DIM = 64
N_HEADS = D_MODEL // HEAD_DIM
N_KV_HEADS = 4
Q_PER_KV = N_HEADS // N_KV_HEADS
WINDOW = 128
ATT_BLOCK = 128
KEY_SPAN = ATT_BLOCK + 2 * WINDOW
ODD_IN = (N_HEADS + 2 * N_KV_HEADS) * HEAD_DIM
REL_BUCKETS = 32
REL_MAX_DIST = 128
D_FF = int(math.ceil(8 * D_MODEL / 3 / 256)) * 256
EPS = 1e-6
NEG_INF = -1e30

kernel_name = "hybrid_s5_gmlp_swa_encoder"


def _rmsnorm(x, g):
    xf = x.astype(jnp.float32)
    y = xf * lax.rsqrt(jnp.mean(xf * xf, axis=-1, keepdims=True) + EPS)
    return (y * g.astype(jnp.float32)).astype(x.dtype)


def _cscan_op(e1, e2):
    a1r, a1i, b1r, b1i = e1
    a2r, a2i, b2r, b2i = e2
    return (a2r * a1r - a2i * a1i,
            a2r * a1i + a2i * a1r,
            a2r * b1r - a2i * b1i + b2r,
            a2r * b1i + a2i * b1r + b2i)


def _s5_mixer(u, lam_re, lam_im, log_dt, b_re, b_im, c_re, c_im, d_skip, glu_w, glu_b):
    bsz, L, _ = u.shape
    uf = u.astype(jnp.float32).reshape(bsz, L, SSM_GROUPS, SSM_GROUP)
    y = uf * d_skip.astype(jnp.float32).reshape(SSM_GROUPS, SSM_GROUP)
    for direction in range(2):
        lr = lam_re[direction].astype(jnp.float32)
        li = lam_im[direction].astype(jnp.float32)
        dt = jnp.exp(log_dt[direction].astype(jnp.float32))[:, None]
        mag = jnp.exp(lr * dt)
        ar = mag * jnp.cos(li * dt)
        ai = mag * jnp.sin(li * dt)
        den = lr * lr + li * li
        zr = ((ar - 1.0) * lr + ai * li) / den
        zi = (ai * lr - (ar - 1.0) * li) / den
        br = b_re[direction].astype(jnp.float32)
        bi = b_im[direction].astype(jnp.float32)
        bbr = zr[..., None] * br - zi[..., None] * bi
        bbi = zr[..., None] * bi + zi[..., None] * br
        xr = jnp.einsum('blgh,gph->blgp', uf, bbr)
        xi = jnp.einsum('blgh,gph->blgp', uf, bbi)
        a_r = jnp.broadcast_to(ar[None, None], (1, L, SSM_GROUPS, SSM_STATE))
        a_i = jnp.broadcast_to(ai[None, None], (1, L, SSM_GROUPS, SSM_STATE))
        _, _, sr, si = lax.associative_scan(_cscan_op, (a_r, a_i, xr, xi), reverse=(direction == 1), axis=1)
        y = y + jnp.einsum('blgp,ghp->blgh', sr, c_re[direction].astype(jnp.float32)) \
              - jnp.einsum('blgp,ghp->blgh', si, c_im[direction].astype(jnp.float32))
    y = jax.nn.gelu(y.reshape(bsz, L, SSM_WIDTH))
    y = y * jax.nn.sigmoid(y @ glu_w.astype(jnp.float32) + glu_b.astype(jnp.float32))
    return y.astype(u.dtype)


def _spatial_gating(z_u, z_v, gm_norm, gm_w_s, gm_b_s):
    bsz, L, _ = z_u.shape
    nc = L // GM_CHUNK
    v = _rmsnorm(z_v.reshape(bsz, nc, GM_CHUNK, GM_HEADS, GM_HEAD_DIM), gm_norm)
    mixed = jnp.einsum('hij,bnjhd->bnihd', gm_w_s, v) + gm_b_s.T[None, None, :, :, None]
    return z_u * mixed.reshape(bsz, L, GM_WIDTH).astype(z_u.dtype)


def _rel_bucket(rel):
    half = REL_BUCKETS // 2
    max_exact = half // 2
    ret = (rel > 0).astype(jnp.int32) * half
    n = jnp.abs(rel)
    nf = jnp.maximum(n, 1).astype(jnp.float32)
    large = max_exact + (jnp.log(nf / max_exact) / math.log(REL_MAX_DIST / max_exact)
                         * (half - max_exact)).astype(jnp.int32)
    large = jnp.minimum(large, half - 1)
    return ret + jnp.where(n < max_exact, n, large)


def _window_attention(h, w_qkv, q_norm, k_norm, attn_sink, rel_table, w_o):
    bsz, L, _ = h.shape
    qkv = h @ w_qkv
    q = qkv[..., :N_HEADS * HEAD_DIM].reshape(bsz, L, N_HEADS, HEAD_DIM)
    k = qkv[..., N_HEADS * HEAD_DIM:(N_HEADS + N_KV_HEADS) * HEAD_DIM].reshape(bsz, L, N_KV_HEADS, HEAD_DIM)
    v = qkv[..., (N_HEADS + N_KV_HEADS) * HEAD_DIM:].reshape(bsz, L, N_KV_HEADS, HEAD_DIM)
    q = _rmsnorm(q, q_norm) * (HEAD_DIM ** -0.5)
    k = _rmsnorm(k, k_norm)
    pad = ((0, 0), (WINDOW, WINDOW), (0, 0), (0, 0))
    kp = jnp.pad(k, pad)
    vp = jnp.pad(v, pad)
    nb = L // ATT_BLOCK
    qi = jnp.arange(ATT_BLOCK)[:, None]
    kj = jnp.arange(KEY_SPAN)[None, :]
    rel = kj - WINDOW - qi
    band = jnp.abs(rel) <= WINDOW
    bias = rel_table[_rel_bucket(rel)].transpose(2, 0, 1).astype(jnp.float32)
    sink = attn_sink.astype(jnp.float32)[None, :, None]

    def block(b):
        start = b * ATT_BLOCK
        qb = lax.dynamic_slice_in_dim(q, start, ATT_BLOCK, axis=1)
        qb = qb.reshape(bsz, ATT_BLOCK, N_KV_HEADS, Q_PER_KV, HEAD_DIM)
        kb = lax.dynamic_slice_in_dim(kp, start, KEY_SPAN, axis=1)
        vb = lax.dynamic_slice_in_dim(vp, start, KEY_SPAN, axis=1)
        s = jnp.einsum('bqkgd,bskd->bkgqs', qb, kb).astype(jnp.float32)
        s = s.reshape(bsz, N_HEADS, ATT_BLOCK, KEY_SPAN) + bias
        kpos = start - WINDOW + jnp.arange(KEY_SPAN)
        valid = band & ((kpos >= 0) & (kpos < L))[None, :]
        s = jnp.where(valid, s, NEG_INF)
        m = jnp.maximum(jnp.max(s, axis=-1), sink)
        p = jnp.exp(s - m[..., None])
        p = p / (jnp.sum(p, axis=-1) + jnp.exp(sink - m))[..., None]
        p = p.reshape(bsz, N_KV_HEADS, Q_PER_KV, ATT_BLOCK, KEY_SPAN).astype(vb.dtype)
        o = jnp.einsum('bkgqs,bskd->bqkgd', p, vb)
        return o.reshape(bsz, ATT_BLOCK, D_MODEL)

    out = lax.map(block, jnp.arange(nb))
    out = out.transpose(1, 0, 2, 3).reshape(bsz, L, D_MODEL)
    return out @ w_o


def _swiglu(h, w_gate, w_up, w_down):
    return (jax.nn.silu(h @ w_gate) * (h @ w_up)) @ w_down


def _trunk(x, norm_mix, norm_ffn, w_in_even, ssm_lam_re, ssm_lam_im, ssm_log_dt, ssm_b_re, ssm_b_im,
           ssm_c_re, ssm_c_im, ssm_d, glu_w, glu_b, gm_norm, gm_w_s, gm_b_s, w_out_even,
           w_qkv, q_norm, k_norm, attn_sink, w_o, rel_table, ffn_w_gate, ffn_w_up, ffn_w_down):
    e = 0
    o = 0
    for layer in range(DEPTH):
        h = _rmsnorm(x, norm_mix[layer])
        if layer % 2 == 0:
            z = h @ w_in_even[e]
            u_a = z[..., :SSM_WIDTH]
            u_b = jax.nn.gelu(z[..., SSM_WIDTH:SSM_WIDTH + GM_WIDTH])
            v_b = jax.nn.gelu(z[..., SSM_WIDTH + GM_WIDTH:])
            y_a = _s5_mixer(u_a, ssm_lam_re[e], ssm_lam_im[e], ssm_log_dt[e], ssm_b_re[e], ssm_b_im[e],
                            ssm_c_re[e], ssm_c_im[e], ssm_d[e], glu_w[e], glu_b[e])
            y_b = _spatial_gating(u_b, v_b, gm_norm[e], gm_w_s[e], gm_b_s[e])
            mix = jnp.concatenate([y_a, y_b], axis=-1) @ w_out_even[e]
            e += 1
        else:
            mix = _window_attention(h, w_qkv[o], q_norm[o], k_norm[o], attn_sink[o], rel_table, w_o[o])
            o += 1
        x = x + mix.astype(x.dtype)
        x = x + _swiglu(_rmsnorm(x, norm_ffn[layer]), ffn_w_gate[layer], ffn_w_up[layer],
                        ffn_w_down[layer]).astype(x.dtype)
    return x


def setup_inputs(seed: int = 0) -> dict:
    key = jax.random.key(seed)
    ks = jax.random.split(key, 32)
    f32 = jnp.float32
    nrm = lambda k, shape, s: jax.random.normal(k, shape, f32) * s
    P, G, H = SSM_STATE, SSM_GROUPS, SSM_GROUP
    lam_im_base = jnp.broadcast_to(jnp.pi * jnp.arange(P, dtype=f32), (N_EVEN, 2, G, P))
    return {
        "x_prompt": jax.random.normal(ks[0], (BATCH, SEQ, D_MODEL), f32),
        "x_sample": jax.random.normal(ks[1], (DEC_BATCH, DEC_SEQ, D_MODEL), f32),
        "norm_mix": 1.0 + nrm(ks[2], (DEPTH, D_MODEL), 0.01),
        "norm_ffn": 1.0 + nrm(ks[3], (DEPTH, D_MODEL), 0.01),
        "w_in_even": nrm(ks[4], (N_EVEN, D_MODEL, EVEN_IN), D_MODEL ** -0.5),
        "ssm_lam_re": -0.5 + nrm(ks[5], (N_EVEN, 2, G, P), 0.01),
        "ssm_lam_im": lam_im_base + nrm(ks[6], (N_EVEN, 2, G, P), 0.01),
        "ssm_log_dt": jax.random.uniform(ks[7], (N_EVEN, 2, G), f32, math.log(DT_MIN), math.log(DT_MAX)),
        "ssm_b_re": nrm(ks[8], (N_EVEN, 2, G, P, H), (2.0 * H) ** -0.5),
        "ssm_b_im": nrm(ks[9], (N_EVEN, 2, G, P, H), (2.0 * H) ** -0.5),
        "ssm_c_re": nrm(ks[10], (N_EVEN, 2, G, H, P), (2.0 / P) ** 0.5),
        "ssm_c_im": nrm(ks[11], (N_EVEN, 2, G, H, P), (2.0 / P) ** 0.5),
        "ssm_d": nrm(ks[12], (N_EVEN, SSM_WIDTH), 1.0),
        "glu_w": nrm(ks[13], (N_EVEN, SSM_WIDTH, SSM_WIDTH), SSM_WIDTH ** -0.5),
        "glu_b": nrm(ks[14], (N_EVEN, SSM_WIDTH), 0.01),
        "gm_norm": 1.0 + nrm(ks[15], (N_EVEN, GM_HEADS, GM_HEAD_DIM), 0.01),
        "gm_w_s": nrm(ks[16], (N_EVEN, GM_HEADS, GM_CHUNK, GM_CHUNK), GM_CHUNK ** -0.5),
        "gm_b_s": 1.0 + nrm(ks[17], (N_EVEN, GM_HEADS, GM_CHUNK), 0.1),
        "w_out_even": nrm(ks[18], (N_EVEN, D_MODEL, D_MODEL), D_MODEL ** -0.5),
        "w_qkv": nrm(ks[19], (N_ODD, D_MODEL, ODD_IN), D_MODEL ** -0.5),
        "q_norm": 1.0 + nrm(ks[20], (N_ODD, HEAD_DIM), 0.01),
        "k_norm": 1.0 + nrm(ks[21], (N_ODD, HEAD_DIM), 0.01),
        "attn_sink": nrm(ks[22], (N_ODD, N_HEADS), 0.5),
        "w_o": nrm(ks[23], (N_ODD, D_MODEL, D_MODEL), D_MODEL ** -0.5),
        "rel_table": nrm(ks[24], (REL_BUCKETS, N_HEADS), 0.5),
        "ffn_w_gate": nrm(ks[25], (DEPTH, D_MODEL, D_FF), D_MODEL ** -0.5),
        "ffn_w_up": nrm(ks[26], (DEPTH, D_MODEL, D_FF), D_MODEL ** -0.5),
        "ffn_w_down": nrm(ks[27], (DEPTH, D_FF, D_MODEL), D_FF ** -0.5),
    }


def reference(x_prompt, x_sample, norm_mix, norm_ffn, w_in_even, ssm_lam_re, ssm_lam_im, ssm_log_dt,
              ssm_b_re, ssm_b_im, ssm_c_re, ssm_c_im, ssm_d, glu_w, glu_b, gm_norm, gm_w_s, gm_b_s,
              w_out_even, w_qkv, q_norm, k_norm, attn_sink, w_o, rel_table, ffn_w_gate, ffn_w_up,
              ffn_w_down):
    y_prompt = _trunk(x_prompt, norm_mix, norm_ffn, w_in_even, ssm_lam_re, ssm_lam_im, ssm_log_dt,
                      ssm_b_re, ssm_b_im, ssm_c_re, ssm_c_im, ssm_d, glu_w, glu_b, gm_norm, gm_w_s, gm_b_s,
                      w_out_even, w_qkv, q_norm, k_norm, attn_sink, w_o, rel_table, ffn_w_gate, ffn_w_up,
                      ffn_w_down)
    y_sample = _trunk(x_sample, norm_mix, norm_ffn, w_in_even, ssm_lam_re, ssm_lam_im, ssm_log_dt,
                      ssm_b_re, ssm_b_im, ssm_c_re, ssm_c_im, ssm_d, glu_w, glu_b, gm_norm, gm_w_s, gm_b_s,
                      w_out_even, w_qkv, q_norm, k_norm, attn_sink, w_o, rel_table, ffn_w_gate, ffn_w_up,
                      ffn_w_down)
    return (y_prompt, y_sample)
```

```cpp
#include <hip/hip_runtime.h>
#include <hip/hip_cooperative_groups.h>
#include <cstdio>
#include <cstdint>
namespace cg = cooperative_groups;

#define LAS __attribute__((address_space(3)))
typedef unsigned short bf16_t;
typedef short bf16x8 __attribute__((ext_vector_type(8)));
typedef float f32x4 __attribute__((ext_vector_type(4)));
typedef float f32x2 __attribute__((ext_vector_type(2)));
typedef unsigned u32x4 __attribute__((ext_vector_type(4)));
typedef unsigned u32x2 __attribute__((ext_vector_type(2)));

constexpr int MP = 16384, MT = 81920;
constexpr int DM = 1024, DFF = 2816, NGU = 2 * DFF;
constexpr int NCH = MT / 16;
constexpr float EPS = 1e-6f;

constexpr size_t MiB = 1u << 20;
constexpr size_t WS_WIN = 0, WS_WQKV = 3 * MiB, WS_WOUT = 6 * MiB, WS_WO = 8 * MiB, WS_WGLU = 10 * MiB;
constexpr size_t WS_WGU0 = 11 * MiB, WS_WGU1 = 22 * MiB, WS_WD0 = 33 * MiB, WS_WD1 = 39 * MiB;
constexpr size_t WS_B1 = 45 * MiB, WS_B3 = 53 * MiB, WS_AT = 61 * MiB, WS_BIAS = 61 * MiB + 65536;
constexpr size_t WS_R1 = 64 * MiB;
constexpr size_t WS_R2 = 224 * MiB;
constexpr size_t WS_A2 = WS_R2, WS_UB = WS_R2 + 160 * MiB, WS_VB = WS_R2 + 240 * MiB, WS_E = WS_R2 + 320 * MiB;
constexpr size_t WS_BAR = 63 * MiB + 512 * 1024;
constexpr size_t WS_SSQ = 62 * MiB;
constexpr size_t WS_XB = WS_R2 + 480 * MiB;
constexpr size_t WS_YG = WS_E + 80 * MiB;
constexpr size_t WS_END = WS_XB + 160 * MiB;

__device__ __forceinline__ int fresh_tid() { int t = threadIdx.x; asm volatile("" : "+v"(t)); return t; }
__device__ __forceinline__ unsigned cvt_pk_bf16(float lo, float hi) { unsigned r; asm volatile("v_cvt_pk_bf16_f32 %0, %1, %2" : "=v"(r) : "v"(lo), "v"(hi)); return r; }
__device__ __forceinline__ float bf_lo(unsigned w) { return __uint_as_float(w << 16); }
__device__ __forceinline__ float bf_hi(unsigned w) { return __uint_as_float(w & 0xffff0000u); }
__device__ __forceinline__ float sigmoid_f(float x) { return __builtin_amdgcn_rcpf(1.0f + __expf(-x)); }
__device__ __forceinline__ float gelu_f(float v) {
    const float p = __builtin_fmaf(v * v, -0.10294324f, -2.3022082f); return v * __builtin_amdgcn_rcpf(1.0f + __builtin_amdgcn_exp2f(v * p)); }

namespace pg8 {
constexpr int BM = 256, BK = 64, HALF = 128, HTB = HALF * BK * 2, STAGE_BYTES = 8 * HTB, NXCD = 8, WGM = 4;
__host__ __device__ __forceinline__ int lds_byte(int r, int c) { const int st = (r >> 4) * 2 + (c >> 5), rr = r & 15, cc = c & 31, ob = rr * 64 + cc * 2; return st * 1024 + (ob ^ (((ob >> 9) & 1) << 5)); }
__host__ __device__ __forceinline__ void stage_rc(int b, int& R, int& C) { const int st = b / 1024, sb = b % 1024, swz = sb ^ (((sb >> 9) & 1) << 5); R = (st >> 1) * 16 + swz / 64; C = (st & 1) * 32 + (swz % 64) / 2; }
__host__ __device__ __forceinline__ int perm32(int rho) { const int n = rho >> 4, i = rho & 15; return 8 * (i >> 2) + 4 * n + (i & 3); }

struct Unit { int pm, pn; };
struct Gemm { const bf16_t* A; const bf16_t* Bt; int K, lda, ldb; };

struct StaticOrder {
    int nM, nN, nwg, G, c; bool rev;
    __device__ void init(int M, int N, int G_, int c_, bool rev_ = false) { nM = M / BM; nN = N / BM; nwg = nM * nN; G = G_; c = c_; rev = rev_; }
    __device__ bool next(int i, Unit& u) const {
        const long L = (long)i * G + c; if (L >= nwg) return false;
        int wgid = (int)L; { const int q = nwg / NXCD, r = nwg % NXCD, xcd = wgid % NXCD, off = wgid / NXCD; wgid = (xcd < r ? xcd * (q + 1) : r * (q + 1) + (xcd - r) * q) + off; }
        const int nig = WGM * nN, gid = wgid / nig, fm = gid * WGM, gsz = (nM - fm) < WGM ? (nM - fm) : WGM;
        u.pm = fm + ((wgid % nig) % gsz); u.pn = (wgid % nig) / gsz; if (rev) u.pm = nM - 1 - u.pm; return true;
    }
};
struct GroupedOrder {
    int G, c;
    __device__ bool next(int i, Unit& u) const { const int L = i * G + c; if (L >= 640) return false; u.pm = L; u.pn = L / 20; return true; }
};

template <class Epi, class Sched>
__device__ __forceinline__ void gemm_phase(LAS unsigned char* lds, const Gemm g, const Sched& S, const Epi& E) {
    const int tid = fresh_tid(), wid = __builtin_amdgcn_readfirstlane(tid >> 6), lane = tid & 63, wr = wid >> 2, wc = wid & 3, fr = lane & 15, fq = lane >> 4;
    const int K = g.K, nt = K / BK;
    unsigned voffA[2], voffB[2];
#pragma unroll
    for (int i = 0; i < 2; ++i) { int R, C; stage_rc(tid * 16 + i * 8192, R, C); const int Rb = Epi::PERM ? ((R & ~31) + perm32(R & 31)) : R;
        voffA[i] = (unsigned)(R * g.lda + C) * 2u; voffB[i] = (unsigned)(Rb * g.ldb + C) * 2u; }
    const size_t kstep = (size_t)(BK * 2);
    const size_t hA = (size_t)HALF * g.lda * 2, hB = (size_t)HALF * g.ldb * 2;
    const size_t tA = 2 * hA, tB = 2 * hB;
    const unsigned ldsw = (unsigned)wid * 1024u;
    const int aoff = lds_byte(wr * 64 + fr, fq * 8), boff = lds_byte(wc * 32 + fr, fq * 8);
#define PG8_SA(b, h) (((b) * 2 + (h)) * HTB)
#define PG8_SB(b, h) ((4 + (b) * 2 + (h)) * HTB)
#define PG8_STAGE(bufoff, gbase, voff) do { _Pragma("unroll") for (int _i = 0; _i < 2; ++_i) \
        __builtin_amdgcn_global_load_lds((const unsigned*)((const char*)(gbase) + (voff)[_i]), (LAS unsigned*)(lds + (bufoff) + ldsw + _i * 8192), 16, 0, 0); } while (0)
#define PG8_LDA(dst, b, h) do { _Pragma("unroll") for (int m = 0; m < 4; ++m) _Pragma("unroll") for (int k = 0; k < 2; ++k) dst[m][k] = *(const LAS bf16x8*)(lds + PG8_SA(b, h) + aoff + m * 2048 + k * 1024); } while (0)
#define PG8_LDB(dst, b, h) do { _Pragma("unroll") for (int n = 0; n < 2; ++n) _Pragma("unroll") for (int k = 0; k < 2; ++k) dst[n][k] = *(const LAS bf16x8*)(lds + PG8_SB(b, h) + boff + n * 2048 + k * 1024); } while (0)
#define PG8_MMA(ai, bj, At, Bt) do { __builtin_amdgcn_s_setprio(1); _Pragma("unroll") for (int m = 0; m < 4; ++m) _Pragma("unroll") for (int n = 0; n < 2; ++n) _Pragma("unroll") for (int k = 0; k < 2; ++k) \
        acc[ai][bj][m][n] = __builtin_amdgcn_mfma_f32_16x16x32_bf16(Bt[n][k], At[m][k], acc[ai][bj][m][n], 0, 0, 0); __builtin_amdgcn_s_setprio(0); } while (0)
#define PG8_WAIT_V(n) asm volatile("s_waitcnt vmcnt(" #n ")" ::: "memory")
#define PG8_WAIT_L(n) asm volatile("s_waitcnt lgkmcnt(" #n ")" ::: "memory")
#define PG8_BAR __builtin_amdgcn_s_barrier()
#define PG8_SCHED __builtin_amdgcn_sched_barrier(0)
    Unit cur, nxt; int ui = 0;
    if (!S.next(0, cur)) return;
    f32x4 acc[2][2][4][2];
#pragma unroll
    for (int a = 0; a < 2; ++a)
#pragma unroll
        for (int b = 0; b < 2; ++b)
#pragma unroll
            for (int m = 0; m < 4; ++m)
#pragma unroll
                for (int n = 0; n < 2; ++n) acc[a][b][m][n] = (f32x4){0.f, 0.f, 0.f, 0.f};
    bf16x8 At[4][2], B0[2][2], B1[2][2];
    const char* cA = (const char*)g.A + (size_t)cur.pm * tA; const char* cB = (const char*)g.Bt + (size_t)cur.pn * tB;
    PG8_STAGE(PG8_SB(0, 0), cB, voffB); PG8_STAGE(PG8_SB(0, 1), cB + hB, voffB); PG8_STAGE(PG8_SA(0, 0), cA, voffA); PG8_STAGE(PG8_SA(0, 1), cA + hA, voffA);
    if (wr == 1) PG8_BAR;
    PG8_WAIT_V(2); PG8_BAR;
    PG8_STAGE(PG8_SB(1, 0), cB + kstep, voffB); PG8_STAGE(PG8_SA(1, 0), cA + kstep, voffA); PG8_STAGE(PG8_SB(1, 1), cB + hB + kstep, voffB);
    PG8_WAIT_V(6); PG8_BAR;
    for (;;) {
        const bool has_next = S.next(ui + 1, nxt);
        const char* nA = has_next ? (const char*)g.A + (size_t)nxt.pm * tA : cA; const char* nB = has_next ? (const char*)g.Bt + (size_t)nxt.pn * tB : cB;
        for (int t = 0; t < nt; t += 2) {
            const bool last = (t == nt - 2);
            const char* a1 = cA + (size_t)(t + 1) * kstep;
            const char* a2 = last ? nA : cA + (size_t)(t + 2) * kstep; const char* b2 = last ? nB : cB + (size_t)(t + 2) * kstep;
            const char* a3 = a2 + kstep; const char* b3 = b2 + kstep;
            PG8_LDB(B0, 0, 0); PG8_LDB(B1, 0, 1); PG8_SCHED; PG8_LDA(At, 0, 0); PG8_STAGE(PG8_SA(1, 1), a1 + hA, voffA);
            PG8_WAIT_V(8); PG8_WAIT_L(0); PG8_BAR; PG8_MMA(0, 0, At, B0); PG8_MMA(0, 1, At, B1); PG8_BAR; PG8_SCHED;
            PG8_LDA(At, 0, 1); PG8_STAGE(PG8_SB(0, 0), b2, voffB); PG8_STAGE(PG8_SB(0, 1), b2 + hB, voffB); PG8_STAGE(PG8_SA(0, 0), a2, voffA);
            PG8_WAIT_V(8); PG8_WAIT_L(0); PG8_BAR; PG8_MMA(1, 0, At, B0); PG8_MMA(1, 1, At, B1); PG8_BAR; PG8_SCHED;
            PG8_LDB(B0, 1, 0); PG8_LDB(B1, 1, 1); PG8_SCHED; PG8_LDA(At, 1, 0); PG8_STAGE(PG8_SA(0, 1), a2 + hA, voffA);
            PG8_WAIT_V(8); PG8_WAIT_L(0); PG8_BAR; PG8_MMA(0, 0, At, B0); PG8_MMA(0, 1, At, B1); PG8_BAR; PG8_SCHED;
            PG8_LDA(At, 1, 1); PG8_STAGE(PG8_SB(1, 0), b3, voffB); PG8_STAGE(PG8_SB(1, 1), b3 + hB, voffB); PG8_STAGE(PG8_SA(1, 0), a3, voffA);
            PG8_WAIT_V(8); PG8_WAIT_L(0); PG8_BAR; PG8_MMA(1, 0, At, B0); PG8_MMA(1, 1, At, B1); PG8_BAR; PG8_SCHED;
        }
        if (wr == 0) PG8_BAR;
        E(acc, cur, wr, wc, fr, fq);
        if (!has_next) break;
#pragma unroll
        for (int a = 0; a < 2; ++a)
#pragma unroll
            for (int b = 0; b < 2; ++b)
#pragma unroll
                for (int m = 0; m < 4; ++m)
#pragma unroll
                    for (int n = 0; n < 2; ++n) acc[a][b][m][n] = (f32x4){0.f, 0.f, 0.f, 0.f};
        cur = nxt; cA = nA; cB = nB; ++ui;
        if (wr == 1) PG8_BAR;
    }
    PG8_WAIT_V(0);
    PG8_BAR;
#undef PG8_SA
#undef PG8_SB
#undef PG8_STAGE
#undef PG8_LDA
#undef PG8_LDB
#undef PG8_MMA
#undef PG8_WAIT_V
#undef PG8_WAIT_L
#undef PG8_BAR
#undef PG8_SCHED
}

typedef f32x4 Acc[2][2][4][2];

struct EpiIn {
    static constexpr bool PERM = true;
    bf16_t* A2; bf16_t* UB; bf16_t* VB;
    __device__ __forceinline__ void operator()(const Acc& acc, const Unit& u, int wr, int wc, int fr, int fq) const {
        const int row0 = u.pm * BM + wr * 64 + fr; const int part = u.pn >> 1;
#pragma unroll
        for (int ai = 0; ai < 2; ++ai)
#pragma unroll
            for (int m = 0; m < 4; ++m) { const int row = row0 + ai * HALF + m * 16;
#pragma unroll
                for (int bj = 0; bj < 2; ++bj) { const int col = u.pn * BM + bj * HALF + wc * 32 + 8 * fq;
                    f32x4 v0 = acc[ai][bj][m][0], v1 = acc[ai][bj][m][1]; bf16_t* dst;
                    if (part == 0) { const int g = col >> 4, h0 = col & 15, bc = row >> 4, j = row & 15; dst = A2 + ((size_t)(g * NCH + bc) * 512 + j * 16 + h0); }
                    else { for (int e = 0; e < 4; ++e) { v0[e] = gelu_f(v0[e]); v1[e] = gelu_f(v1[e]); } dst = (part == 1 ? UB : VB) + (size_t)row * 512 + (col - 512 * part); }
                    u32x4 w; w.x = cvt_pk_bf16(v0[0], v0[1]); w.y = cvt_pk_bf16(v0[2], v0[3]); w.z = cvt_pk_bf16(v1[0], v1[1]); w.w = cvt_pk_bf16(v1[2], v1[3]);
                    *(u32x4*)dst = w; } }
    }
};
struct EpiE {
    static constexpr bool PERM = false;
    bf16_t* E;
    __device__ __forceinline__ void operator()(const Acc& acc, const Unit& u, int wr, int wc, int fr, int fq) const {
#pragma unroll
        for (int ai = 0; ai < 2; ++ai)
#pragma unroll
            for (int m = 0; m < 4; ++m) { bf16_t* rp = E + (size_t)(u.pm * BM + ai * HALF + wr * 64 + m * 16 + fr) * 256 + wc * 32 + 4 * fq;
#pragma unroll
                for (int bj = 0; bj < 2; ++bj)
#pragma unroll
                    for (int n = 0; n < 2; ++n) { const f32x4 v = acc[ai][bj][m][n]; u32x2 w; w.x = cvt_pk_bf16(v[0], v[1]); w.y = cvt_pk_bf16(v[2], v[3]); *(u32x2*)(rp + bj * HALF + n * 16) = w; } }
    }
};
struct EpiS3 {
    static constexpr bool PERM = true;
    bf16_t* YG;
    __device__ __forceinline__ void operator()(const Acc& acc, const Unit& u, int wr, int wc, int fr, int fq) const {
        const int g = u.pn;
#pragma unroll
        for (int ai = 0; ai < 2; ++ai)
#pragma unroll
            for (int m = 0; m < 4; ++m) { const int bc = u.pm * BM + ai * HALF + wr * 64 + m * 16 + fr - g * NCH;
#pragma unroll
                for (int bj = 0; bj < 2; ++bj) { const int n0 = bj * HALF + wc * 32 + 8 * fq, i = n0 >> 4, hp = n0 & 15;
                    f32x4 v0 = acc[ai][bj][m][0], v1 = acc[ai][bj][m][1];
                    for (int e = 0; e < 4; ++e) { v0[e] = gelu_f(v0[e]); v1[e] = gelu_f(v1[e]); }
                    u32x4 w; w.x = cvt_pk_bf16(v0[0], v0[1]); w.y = cvt_pk_bf16(v0[2], v0[3]); w.z = cvt_pk_bf16(v1[0], v1[1]); w.w = cvt_pk_bf16(v1[2], v1[3]);
                    *(u32x4*)(YG + (size_t)(bc * 16 + i) * 512 + g * 16 + hp) = w; } }
    }
};
struct EpiGlu {
    static constexpr bool PERM = true;
    const bf16_t* YG; const float* bias; bf16_t* YAB;
    __device__ __forceinline__ void operator()(const Acc& acc, const Unit& u, int wr, int wc, int fr, int fq) const {
        const int row0 = u.pm * BM + wr * 64 + fr;
#pragma unroll
        for (int ai = 0; ai < 2; ++ai)
#pragma unroll
            for (int m = 0; m < 4; ++m) { const int row = row0 + ai * HALF + m * 16;
#pragma unroll
                for (int bj = 0; bj < 2; ++bj) { const int col = u.pn * BM + bj * HALF + wc * 32 + 8 * fq;
                    const u32x4 yv = *(const u32x4*)(YG + (size_t)row * 512 + col);
                    const f32x4 b0 = *(const f32x4*)(bias + col), b1 = *(const f32x4*)(bias + col + 4);
                    const f32x4 v0 = acc[ai][bj][m][0] + b0, v1 = acc[ai][bj][m][1] + b1;
                    u32x4 w;
                    w.x = cvt_pk_bf16(bf_lo(yv.x) * sigmoid_f(v0[0]), bf_hi(yv.x) * sigmoid_f(v0[1]));
                    w.y = cvt_pk_bf16(bf_lo(yv.y) * sigmoid_f(v0[2]), bf_hi(yv.y) * sigmoid_f(v0[3]));
                    w.z = cvt_pk_bf16(bf_lo(yv.z) * sigmoid_f(v1[0]), bf_hi(yv.z) * sigmoid_f(v1[1]));
                    w.w = cvt_pk_bf16(bf_lo(yv.w) * sigmoid_f(v1[2]), bf_hi(yv.w) * sigmoid_f(v1[3]));
                    *(u32x4*)(YAB + (size_t)row * 1024 + col) = w; } }
    }
};
template <int MODE> struct EpiRes {
    static constexpr bool PERM = true;
    const float* base0; const float* base1; float* out; bf16_t* XB; float* ssq;
    __device__ __forceinline__ void operator()(const Acc& acc, const Unit& u, int wr, int wc, int fr, int fq) const {
        const int row0 = u.pm * BM + wr * 64 + fr; const int col0 = u.pn * BM + wc * 32 + 8 * fq;
        const float* bp = (MODE == 0) ? ((u.pm < MP / BM) ? base0 : base1) : nullptr;
#pragma unroll
        for (int ai = 0; ai < 2; ++ai) {
            f32x4 bv[4][2][2];
#pragma unroll
            for (int m = 0; m < 4; ++m) { const size_t off = (size_t)(row0 + ai * HALF + m * 16) * DM + col0;
#pragma unroll
                for (int bj = 0; bj < 2; ++bj) {
                    if (MODE == 0) { bv[m][bj][0] = *(const f32x4*)(bp + off + bj * HALF); bv[m][bj][1] = *(const f32x4*)(bp + off + bj * HALF + 4); }
                    else if (MODE == 3) { const u32x4 xv = *(const u32x4*)(XB + off + bj * HALF); const float rn = sqrtf(base1[row0 + ai * HALF + m * 16] * (1.f / DM) + EPS);
                        bv[m][bj][0] = (f32x4){bf_lo(xv.x), bf_hi(xv.x), bf_lo(xv.y), bf_hi(xv.y)} * rn; bv[m][bj][1] = (f32x4){bf_lo(xv.z), bf_hi(xv.z), bf_lo(xv.w), bf_hi(xv.w)} * rn; }
                    else { const u32x4 xv = *(const u32x4*)(XB + off + bj * HALF); bv[m][bj][0] = (f32x4){bf_lo(xv.x), bf_hi(xv.x), bf_lo(xv.y), bf_hi(xv.y)}; bv[m][bj][1] = (f32x4){bf_lo(xv.z), bf_hi(xv.z), bf_lo(xv.w), bf_hi(xv.w)}; } } }
            asm volatile("" ::: "memory");
#pragma unroll
            for (int m = 0; m < 4; ++m) { const int row = row0 + ai * HALF + m * 16; const size_t off = (size_t)row * DM + col0; float sq = 0.f;
#pragma unroll
                for (int bj = 0; bj < 2; ++bj) {
                    const f32x4 o0 = bv[m][bj][0] + acc[ai][bj][m][0], o1 = bv[m][bj][1] + acc[ai][bj][m][1];
                    if (MODE == 2) { *(f32x4*)(out + off + bj * HALF) = o0; *(f32x4*)(out + off + bj * HALF + 4) = o1; }
                    else { sq += ((o0[0] * o0[0] + o0[1] * o0[1]) + (o0[2] * o0[2] + o0[3] * o0[3])) + ((o1[0] * o1[0] + o1[1] * o1[1]) + (o1[2] * o1[2] + o1[3] * o1[3]));
                        u32x4 w; w.x = cvt_pk_bf16(o0[0], o0[1]); w.y = cvt_pk_bf16(o0[2], o0[3]); w.z = cvt_pk_bf16(o1[0], o1[1]); w.w = cvt_pk_bf16(o1[2], o1[3]); *(u32x4*)(XB + off + bj * HALF) = w; } }
                if (MODE != 2) { sq += __shfl_xor(sq, 16); sq += __shfl_xor(sq, 32); if (fq == 0) unsafeAtomicAdd(ssq + row, sq); } }
            asm volatile("" ::: "memory"); }
    }
};
struct EpiSwiglu {
    static constexpr bool PERM = true;
    bf16_t* HB; const float* ssq;
    __device__ __forceinline__ void operator()(const Acc& acc, const Unit& u, int wr, int wc, int fr, int fq) const {
        const int row0 = u.pm * BM + wr * 64 + fr;
#pragma unroll
        for (int ai = 0; ai < 2; ++ai)
#pragma unroll
            for (int m = 0; m < 4; ++m) { const int row = row0 + ai * HALF + m * 16; bf16_t* rp = HB + (size_t)row * DFF + u.pn * HALF + wc * 32 + 8 * fq;
                const float rstd = rsqrtf(ssq[row] * (1.f / DM) + EPS); const float r2 = rstd * rstd, c1 = rstd * (-1.4426950408889634f);
                u32x4 w;
#pragma unroll
                for (int bj = 0; bj < 2; ++bj) { const f32x4 gt = acc[ai][bj][m][0], up = acc[ai][bj][m][1];
                    f32x4 e = gt * c1;
#pragma unroll
                    for (int q = 0; q < 4; ++q) e[q] = __builtin_amdgcn_exp2f(e[q]);
                    e = e + 1.0f;
#pragma unroll
                    for (int q = 0; q < 4; ++q) e[q] = __builtin_amdgcn_rcpf(e[q]);
                    const f32x4 o = (gt * up) * (e * r2);
                    if (bj == 0) { w.x = cvt_pk_bf16(o[0], o[1]); w.y = cvt_pk_bf16(o[2], o[3]); } else { w.z = cvt_pk_bf16(o[0], o[1]); w.w = cvt_pk_bf16(o[2], o[3]); } }
                *(u32x4*)rp = w; }
    }
};
struct EpiBf16 {
    static constexpr bool PERM = true;
    bf16_t* O; int ldc; const float* ssq;
    __device__ __forceinline__ void operator()(const Acc& acc, const Unit& u, int wr, int wc, int fr, int fq) const {
        const int row0 = u.pm * BM + wr * 64 + fr; const int col0 = u.pn * BM + wc * 32 + 8 * fq;
#pragma unroll
        for (int ai = 0; ai < 2; ++ai)
#pragma unroll
            for (int m = 0; m < 4; ++m) { const int row = row0 + ai * HALF + m * 16; bf16_t* rp = O + (size_t)row * ldc + col0;
                const float rstd = rsqrtf(ssq[row] * (1.f / DM) + EPS);
#pragma unroll
                for (int bj = 0; bj < 2; ++bj) { const f32x4 v0 = acc[ai][bj][m][0] * rstd, v1 = acc[ai][bj][m][1] * rstd;
                    u32x4 w; w.x = cvt_pk_bf16(v0[0], v0[1]); w.y = cvt_pk_bf16(v0[2], v0[3]); w.z = cvt_pk_bf16(v1[0], v1[1]); w.w = cvt_pk_bf16(v1[2], v1[3]);
                    *(u32x4*)(rp + bj * HALF) = w; } }
    }
};
}

constexpr int LDS_BYTES = 147456;
struct Args { const float* in[28]; float* out; unsigned char* ws; };

__device__ __forceinline__ float wave_sum(float v) {
#pragma unroll
    for (int o = 1; o < 64; o <<= 1) v += __shfl_xor(v, o);
    return v;
}

__device__ __forceinline__ void transpose_item(const float* W, int K, int N, bf16_t* WT, int mode, float* scr, int item, int lane, const float* ksc = nullptr) {
    const int nblk = N / 32, kb = item / nblk, nb = item % nblk, k0 = 64 * kb, n0 = 32 * nb;
#pragma unroll 8
    for (int i = 0; i < 32; ++i) { const int kk = 2 * i + (lane >> 5); const float sc = ksc ? ksc[k0 + kk] : 1.0f; scr[kk * 33 + (lane & 31)] = W[(size_t)(k0 + kk) * N + n0 + (lane & 31)] * sc; }
    asm volatile("s_waitcnt lgkmcnt(0)" ::: "memory");
    const int c = lane & 7;
#pragma unroll
    for (int j = 0; j < 4; ++j) { const int nl = (lane >> 3) + 8 * j; const float* s = scr + (8 * c) * 33 + nl; const int n = n0 + nl;
        const int row = mode == 0 ? n : (256 * (n >> 7) + 128 * ((n >> 2) & 1) + 32 * ((n >> 5) & 3) + 8 * ((n >> 3) & 3) + (mode == 2 ? 4 : 0) + (n & 3));
        u32x4 o; o.x = cvt_pk_bf16(s[0 * 33], s[1 * 33]); o.y = cvt_pk_bf16(s[2 * 33], s[3 * 33]); o.z = cvt_pk_bf16(s[4 * 33], s[5 * 33]); o.w = cvt_pk_bf16(s[6 * 33], s[7 * 33]);
        *(u32x4*)(WT + (size_t)row * K + k0 + 8 * c) = o; }
    asm volatile("s_waitcnt lgkmcnt(0)" ::: "memory");
}

__device__ __forceinline__ void rms_rows(const float* src0, const float* src1, const float* gw_, bf16_t* XN, float* ssq) {
    if (blockIdx.x < 32) return;
    const int tid = fresh_tid(), lane = tid & 63, gw = (blockIdx.x - 32) * 8 + (tid >> 6), NGW = (gridDim.x - 32) * 8;
    int m = gw; f32x4 v[4];
    if (m < MT) { const f32x4* xr = (const f32x4*)((m < MP) ? src0 + (size_t)m * DM : src1 + (size_t)(m - MP) * DM) + lane;
#pragma unroll
        for (int j = 0; j < 4; ++j) v[j] = __builtin_nontemporal_load(xr + 64 * j); }
    for (; m < MT; m += NGW) {
        const int m2 = m + NGW; f32x4 nv[4];
        if (m2 < MT) { const f32x4* xr = (const f32x4*)((m2 < MP) ? src0 + (size_t)m2 * DM : src1 + (size_t)(m2 - MP) * DM) + lane;
#pragma unroll
            for (int j = 0; j < 4; ++j) nv[j] = __builtin_nontemporal_load(xr + 64 * j); }
        float s = 0.f;
#pragma unroll
        for (int j = 0; j < 4; ++j) s += (v[j].x * v[j].x + v[j].y * v[j].y) + (v[j].z * v[j].z + v[j].w * v[j].w);
        s = wave_sum(s); if (lane == 0) ssq[m] = s;
        const float rstd = rsqrtf(s * (1.f / DM) + EPS);
        u32x2* o8 = (u32x2*)(XN + (size_t)m * DM) + lane;
#pragma unroll
        for (int j = 0; j < 4; ++j) { u32x2 w; w.x = cvt_pk_bf16(v[j].x * rstd, v[j].y * rstd); w.y = cvt_pk_bf16(v[j].z * rstd, v[j].w * rstd); o8[64 * j] = w; }
        if (m2 < MT) {
#pragma unroll
            for (int j = 0; j < 4; ++j) v[j] = nv[j]; }
    }
}

__device__ __forceinline__ void s5_prep(const Args& a, int g, unsigned char* lds) {
    const int tid = fresh_tid();
    f32x2* apow = (f32x2*)lds;
    f32x2* bbar = apow + 2 * 17 * 64;
    f32x2* zt = bbar + 2 * 64 * 16;
    float* kmat = (float*)(zt + 128);
    const float* lam_re = a.in[5]; const float* lam_im = a.in[6]; const float* log_dt = a.in[7];
    const float* b_re = a.in[8]; const float* b_im = a.in[9]; const float* c_re = a.in[10]; const float* c_im = a.in[11]; const float* d_skip = a.in[12];
    bf16_t* B1 = (bf16_t*)(a.ws + WS_B1) + (size_t)g * 256 * 512;
    bf16_t* B3 = (bf16_t*)(a.ws + WS_B3) + (size_t)g * 256 * 512;
    f32x2* AT = (f32x2*)(a.ws + WS_AT);
    if (tid < 128) {
        const int dir = tid >> 6, p = tid & 63; const int idx = (dir * 32 + g) * 64 + p;
        const float lr = lam_re[idx], li = lam_im[idx], dt = expf(log_dt[dir * 32 + g]);
        for (int k = 0; k <= 16; ++k) { const float mg = expf(lr * dt * (float)k), ang = li * dt * (float)k; apow[(dir * 17 + k) * 64 + p] = (f32x2){mg * cosf(ang), mg * sinf(ang)}; }
        const f32x2 a1 = apow[(dir * 17 + 1) * 64 + p]; const float den = lr * lr + li * li;
        zt[dir * 64 + p] = (f32x2){((a1.x - 1.0f) * lr + a1.y * li) / den, (a1.y * lr - (a1.x - 1.0f) * li) / den};
        AT[idx] = apow[(dir * 17 + 16) * 64 + p];
    }
    __syncthreads();
    for (int e = tid; e < 2048; e += 512) { const int dir = e >> 10, p = (e >> 4) & 63, h = e & 15; const size_t gi = ((size_t)(dir * 32 + g) * 64 + p) * 16 + h;
        const float br = b_re[gi], bi = b_im[gi]; const f32x2 z = zt[dir * 64 + p]; bbar[e] = (f32x2){z.x * br - z.y * bi, z.x * bi + z.y * br}; }
    __syncthreads();
    for (int e = tid; e < 31 * 256; e += 512) { const int lag = e / 256 - 15, hp = (e >> 4) & 15, h = e & 15; float sum = 0.f;
        if (lag >= 0) { const size_t ci = ((size_t)(0 * 32 + g) * 16 + hp) * 64;
            for (int p = 0; p < 64; ++p) { const float cr = c_re[ci + p], cim = c_im[ci + p]; const f32x2 aw = apow[(0 * 17 + lag) * 64 + p]; const f32x2 b = bbar[(0 * 64 + p) * 16 + h];
                const float wr_ = cr * aw.x - cim * aw.y, wi_ = cr * aw.y + cim * aw.x; sum += wr_ * b.x - wi_ * b.y; } }
        if (lag <= 0) { const size_t ci = ((size_t)(1 * 32 + g) * 16 + hp) * 64;
            for (int p = 0; p < 64; ++p) { const float cr = c_re[ci + p], cim = c_im[ci + p]; const f32x2 aw = apow[(1 * 17 - lag) * 64 + p]; const f32x2 b = bbar[(1 * 64 + p) * 16 + h];
                const float wr_ = cr * aw.x - cim * aw.y, wi_ = cr * aw.y + cim * aw.x; sum += wr_ * b.x - wi_ * b.y; } }
        if (lag == 0 && hp == h) sum += d_skip[g * 16 + h];
        kmat[e] = sum; }
    __syncthreads();
    for (int e = tid; e < 256 * 256; e += 512) { const int n = e >> 8, k = (e & 255) * 2; const int i = n >> 4, hp = n & 15; float v0, v1;
        if (k < 256) { const int j = k >> 4, h = k & 15; const float* kp = kmat + (i - j + 15) * 256 + hp * 16 + h; v0 = kp[0]; v1 = kp[1]; }
        else { const int kk = k - 256, dir = kk >> 7, p = (kk >> 1) & 63; const int ee = dir == 0 ? i + 1 : 16 - i; const size_t ci = ((size_t)(dir * 32 + g) * 16 + hp) * 64 + p;
            const float cr = c_re[ci], cim = c_im[ci]; const f32x2 aw = apow[(dir * 17 + ee) * 64 + p]; v0 = cr * aw.x - cim * aw.y; v1 = -(cr * aw.y + cim * aw.x); }
        *(unsigned*)(B3 + (size_t)n * 512 + k) = cvt_pk_bf16(v0, v1); }
    for (int e = tid; e < 256 * 128; e += 512) { const int n = e >> 7, k = (e & 127) * 2; const int dir = n >> 7, p = (n >> 1) & 63, ri = n & 1, j = k >> 4, h = k & 15;
        const int ee = dir == 0 ? 15 - j : j; const f32x2 aw = apow[(dir * 17 + ee) * 64 + p]; const f32x2 b0 = bbar[(dir * 64 + p) * 16 + h], b1 = bbar[(dir * 64 + p) * 16 + h + 1];
        const float v0 = ri ? (aw.x * b0.y + aw.y * b0.x) : (aw.x * b0.x - aw.y * b0.y), v1 = ri ? (aw.x * b1.y + aw.y * b1.x) : (aw.x * b1.x - aw.y * b1.y);
        *(unsigned*)(B1 + (size_t)n * 512 + k) = cvt_pk_bf16(v0, v1); }
    __syncthreads();
}

__device__ __forceinline__ void sg_phase(const Args& a, unsigned char* lds) {
    const int tid = fresh_tid();
    bf16_t* VT = (bf16_t*)lds;
    const bf16_t* VB = (const bf16_t*)(a.ws + WS_VB); const bf16_t* UB = (const bf16_t*)(a.ws + WS_UB); bf16_t* YAB = (bf16_t*)(a.ws + WS_R1);
    const int lane = tid & 63, w = tid >> 6, fr = lane & 15, fq = lane >> 4;
    const int G = gridDim.x; int u = blockIdx.x;
    const int ch = tid & 15, j0 = tid >> 4;
    u32x4 vreg[4];
    if (u < 2560) {
#pragma unroll
        for (int it = 0; it < 4; ++it) vreg[it] = *(const u32x4*)(VB + ((size_t)(u >> 2) * 128 + j0 + 32 * it) * 512 + (u & 3) * 128 + ch * 8); }
    for (; u < 2560; u += G) { const int n = u >> 2, h = u & 3;
        const float* gmn = a.in[15] + h * 128; const float* Ws = a.in[16] + (size_t)h * 128 * 128; const float* bs = a.in[17] + h * 128;
        const int i = 16 * w + fr; const size_t tok = (size_t)n * 128 + i;
        u32x4 ub[4];
#pragma unroll
        for (int q = 0; q < 4; ++q) ub[q] = *(const u32x4*)(UB + tok * 512 + h * 128 + 32 * fq + 8 * q);
        f32x4 wv[4][2];
#pragma unroll
        for (int ks = 0; ks < 4; ++ks) { wv[ks][0] = *(const f32x4*)(Ws + (size_t)i * 128 + ks * 32 + fq * 8); wv[ks][1] = *(const f32x4*)(Ws + (size_t)i * 128 + ks * 32 + fq * 8 + 4); }
        const float bsv = bs[i];
        const f32x4 g0 = *(const f32x4*)(gmn + ch * 8), g1 = *(const f32x4*)(gmn + ch * 8 + 4);
        const float gg[8] = {g0.x, g0.y, g0.z, g0.w, g1.x, g1.y, g1.z, g1.w};
#pragma unroll
        for (int it = 0; it < 4; ++it) { const int j = j0 + 32 * it; const u32x4 v = vreg[it];
            float f[8] = {bf_lo(v.x), bf_hi(v.x), bf_lo(v.y), bf_hi(v.y), bf_lo(v.z), bf_hi(v.z), bf_lo(v.w), bf_hi(v.w)};
            float ss = 0.f;
#pragma unroll
            for (int e = 0; e < 8; ++e) ss += f[e] * f[e];
            ss += __shfl_xor(ss, 1); ss += __shfl_xor(ss, 2); ss += __shfl_xor(ss, 4); ss += __shfl_xor(ss, 8);
            const float rstd = rsqrtf(ss * (1.f / 128.f) + EPS);
#pragma unroll
            for (int e = 0; e < 8; e += 2) { const unsigned pk = cvt_pk_bf16(f[e] * rstd * gg[e], f[e + 1] * rstd * gg[e + 1]);
                const int d = ch * 8 + e, r0 = 16 * ((d >> 2) & 7) + 4 * (d >> 5) + (d & 3);
                VT[r0 * 136 + j] = (bf16_t)(pk & 0xffffu); VT[(r0 + 1) * 136 + j] = (bf16_t)(pk >> 16); } }
        __syncthreads();
        if (u + G < 2560) { const int u2 = u + G;
#pragma unroll
            for (int it = 0; it < 4; ++it) vreg[it] = *(const u32x4*)(VB + ((size_t)(u2 >> 2) * 128 + j0 + 32 * it) * 512 + (u2 & 3) * 128 + ch * 8); }
        bf16x8 bw[4];
#pragma unroll
        for (int ks = 0; ks < 4; ++ks) { const f32x4 w0 = wv[ks][0], w1 = wv[ks][1];
            u32x4 pk; pk.x = cvt_pk_bf16(w0.x, w0.y); pk.y = cvt_pk_bf16(w0.z, w0.w); pk.z = cvt_pk_bf16(w1.x, w1.y); pk.w = cvt_pk_bf16(w1.z, w1.w); bw[ks] = __builtin_bit_cast(bf16x8, pk); }
        f32x4 acc[8];
#pragma unroll
        for (int mt = 0; mt < 8; ++mt) { acc[mt] = (f32x4){0.f, 0.f, 0.f, 0.f};
#pragma unroll
            for (int ks = 0; ks < 4; ++ks) { const bf16x8 av = *(const bf16x8*)(VT + (mt * 16 + fr) * 136 + ks * 32 + fq * 8); acc[mt] = __builtin_amdgcn_mfma_f32_16x16x32_bf16(av, bw[ks], acc[mt], 0, 0, 0); } }
#pragma unroll
        for (int q = 0; q < 4; ++q) { const f32x4 a0 = acc[2 * q] + bsv, a1 = acc[2 * q + 1] + bsv; const u32x4 uv = ub[q]; u32x4 o;
            o.x = cvt_pk_bf16(bf_lo(uv.x) * a0[0], bf_hi(uv.x) * a0[1]); o.y = cvt_pk_bf16(bf_lo(uv.y) * a0[2], bf_hi(uv.y) * a0[3]);
            o.z = cvt_pk_bf16(bf_lo(uv.z) * a1[0], bf_hi(uv.z) * a1[1]); o.w = cvt_pk_bf16(bf_lo(uv.w) * a1[2], bf_hi(uv.w) * a1[3]);
            *(u32x4*)(YAB + tok * 1024 + 512 + h * 128 + 32 * fq + 8 * q) = o; }
        __syncthreads();
    }
}

__device__ __forceinline__ void scan_unit(const Args& a, int unit, int t) {
    const int s = unit >> 5, g = unit & 31; const int nc = s < 4 ? 256 : 512; const int bc0 = s < 4 ? s * 256 : 1024 + (s - 4) * 512;
    const int dir = t >> 6, p = t & 63;
    const f32x2 aT = ((const f32x2*)(a.ws + WS_AT))[(dir * 32 + g) * 64 + p];
    const bf16_t* E = (const bf16_t*)(a.ws + WS_E) + ((size_t)(g * NCH + bc0) * 256 + 2 * t);
    bf16_t* A2 = (bf16_t*)(a.ws + WS_A2) + ((size_t)(g * NCH + bc0) * 512 + 256 + 2 * t);
    float sr = 0.f, si = 0.f;
    for (int c0 = 0; c0 < nc; c0 += 32) {
        unsigned ev[32];
#pragma unroll
        for (int q = 0; q < 32; ++q) { const int c = dir == 0 ? c0 + q : nc - 1 - c0 - q; ev[q] = *(const unsigned*)(E + (size_t)c * 256); }
#pragma unroll
        for (int q = 0; q < 32; ++q) { const int c = dir == 0 ? c0 + q : nc - 1 - c0 - q;
            *(unsigned*)(A2 + (size_t)c * 512) = cvt_pk_bf16(sr, si);
            const float nr = aT.x * sr - aT.y * si + bf_lo(ev[q]), ni = aT.x * si + aT.y * sr + bf_hi(ev[q]); sr = nr; si = ni; }
    }
}

constexpr int KP = 72, VP = 408;
__device__ __forceinline__ void attn_unit(const Args& a, int s, int qb, int kvh, bool cont, unsigned char* lds) {
    const int tid = fresh_tid();
    bf16_t* Kl = (bf16_t*)lds;
    bf16_t* VT = Kl + 400 * KP;
    float* biasL = (float*)(VT + 64 * VP);
    const bf16_t* QKV = (const bf16_t*)(a.ws + WS_R2); bf16_t* O = (bf16_t*)(a.ws + WS_R1);
    const float* qn = a.in[20]; const float* kn = a.in[21]; const float* sinkp = a.in[22]; const float* BIAS = (const float*)(a.ws + WS_BIAS);
    const int L = s < 4 ? 4096 : 8192; const size_t rowbase = s < 4 ? (size_t)s * 4096 : (size_t)MP + (size_t)(s - 4) * 8192;
    const int q0 = qb * 128; const int lane = tid & 63, w = tid >> 6, fr = lane & 15, fq = lane >> 4;
    const bf16_t* qbase = QKV + (rowbase + q0 + (w & 1) * 64 + fr) * 1536 + (kvh * 4 + (w >> 1)) * 64 + fq * 8;
    u32x4 qn0 = *(const u32x4*)qbase, qn1 = *(const u32x4*)(qbase + 32), qn2 = *(const u32x4*)(qbase + 16 * 1536), qn3 = *(const u32x4*)(qbase + 16 * 1536 + 32);
    const int k_lo = cont ? 256 : 0, npieces = (384 - k_lo) * 8;
    u32x4 kvr[6], vvr[6];
#pragma unroll
    for (int it = 0; it < 6; ++it) { const int piece = tid + 512 * it; const int kk = k_lo + (piece >> 3), ch = piece & 7; const int kpos = q0 - 128 + kk; const bool valid = piece < npieces && kpos >= 0 && kpos < L;
        kvr[it] = (u32x4){0u, 0u, 0u, 0u}; vvr[it] = (u32x4){0u, 0u, 0u, 0u};
        if (valid) { const bf16_t* rp = QKV + (rowbase + kpos) * 1536 + kvh * 64 + ch * 8; kvr[it] = *(const u32x4*)(rp + 1024); vvr[it] = *(const u32x4*)(rp + 1280); } }
    const f32x4 g0 = *(const f32x4*)(kn + (tid & 7) * 8), g1 = *(const f32x4*)(kn + (tid & 7) * 8 + 4);
#pragma unroll
    for (int it = 0; it < 6; ++it) { const int piece = tid + 512 * it; const int kk = k_lo + (piece >> 3), ch = piece & 7;
        if (piece < npieces) { const int slot = (q0 + 256 + kk) % 384;
        const u32x4 kv = kvr[it], vv = vvr[it];
        float f[8] = {bf_lo(kv.x), bf_hi(kv.x), bf_lo(kv.y), bf_hi(kv.y), bf_lo(kv.z), bf_hi(kv.z), bf_lo(kv.w), bf_hi(kv.w)};
        float ss = 0.f;
#pragma unroll
        for (int e = 0; e < 8; ++e) ss += f[e] * f[e];
        ss += __shfl_xor(ss, 1); ss += __shfl_xor(ss, 2); ss += __shfl_xor(ss, 4);
        const float rstd = rsqrtf(ss * (1.f / 64.f) + EPS);
        u32x4 o; o.x = cvt_pk_bf16(f[0] * rstd * g0.x, f[1] * rstd * g0.y); o.y = cvt_pk_bf16(f[2] * rstd * g0.z, f[3] * rstd * g0.w);
        o.z = cvt_pk_bf16(f[4] * rstd * g1.x, f[5] * rstd * g1.y); o.w = cvt_pk_bf16(f[6] * rstd * g1.z, f[7] * rstd * g1.w);
        *(u32x4*)(Kl + slot * KP + ch * 8) = o;
        const unsigned vw[4] = {vv.x, vv.y, vv.z, vv.w};
#pragma unroll
        for (int e = 0; e < 4; ++e) { const int d0 = ch * 8 + 2 * e, r0 = ((d0 >> 2) & 3) * 16 + (d0 >> 4) * 4 + (d0 & 3);
            VT[r0 * VP + slot] = (bf16_t)(vw[e] & 0xffffu); VT[(r0 + 1) * VP + slot] = (bf16_t)(vw[e] >> 16); } } }
    if (!cont)
    for (int idx = tid; idx < 4 * 304; idx += 512) { const int hq = idx / 304, ii = idx % 304 - 16; biasL[idx] = (ii >= 0 && ii <= 256) ? BIAS[(kvh * 4 + hq) * 257 + ii] : 0.f; }
    __syncthreads();
    const int hq = w >> 1, H = kvh * 4 + hq; const float sink = sinkp[H] * 1.4426950408889634f; const bool edge = (q0 == 0) || (q0 + 128 == L);
    const float* bl = biasL + hq * 304 + 16;
#define MAKE_QF(R0, R1, QF) { const u32x4 r0 = R0, r1 = R1; \
          float f[16] = {bf_lo(r0.x), bf_hi(r0.x), bf_lo(r0.y), bf_hi(r0.y), bf_lo(r0.z), bf_hi(r0.z), bf_lo(r0.w), bf_hi(r0.w), bf_lo(r1.x), bf_hi(r1.x), bf_lo(r1.y), bf_hi(r1.y), bf_lo(r1.z), bf_hi(r1.z), bf_lo(r1.w), bf_hi(r1.w)}; \
          float ss = 0.f; \
          _Pragma("unroll") for (int e = 0; e < 16; ++e) ss += f[e] * f[e]; \
          ss += __shfl_xor(ss, 16); ss += __shfl_xor(ss, 32); \
          const float rstd = rsqrtf(ss * (1.f / 64.f) + EPS) * (0.125f * 1.4426950408889634f); \
          u32x4 p0, p1; \
          p0.x = cvt_pk_bf16(f[0] * rstd * qg[0].x, f[1] * rstd * qg[0].y); p0.y = cvt_pk_bf16(f[2] * rstd * qg[0].z, f[3] * rstd * qg[0].w); \
          p0.z = cvt_pk_bf16(f[4] * rstd * qg[1].x, f[5] * rstd * qg[1].y); p0.w = cvt_pk_bf16(f[6] * rstd * qg[1].z, f[7] * rstd * qg[1].w); \
          p1.x = cvt_pk_bf16(f[8] * rstd * qg[2].x, f[9] * rstd * qg[2].y); p1.y = cvt_pk_bf16(f[10] * rstd * qg[2].z, f[11] * rstd * qg[2].w); \
          p1.z = cvt_pk_bf16(f[12] * rstd * qg[3].x, f[13] * rstd * qg[3].y); p1.w = cvt_pk_bf16(f[14] * rstd * qg[3].z, f[15] * rstd * qg[3].w); \
          QF[0] = __builtin_bit_cast(bf16x8, p0); QF[1] = __builtin_bit_cast(bf16x8, p1); }
#pragma unroll 1
    for (int pr = 0; pr < 2; ++pr) { const int qs = (w & 1) * 64 + pr * 32;
        bf16x8 qfA[2], qfB[2];
        { f32x4 qg[4];
#pragma unroll
          for (int e = 0; e < 2; ++e) { qg[2 * e] = *(const f32x4*)(qn + e * 32 + fq * 8); qg[2 * e + 1] = *(const f32x4*)(qn + e * 32 + fq * 8 + 4); }
          MAKE_QF(qn0, qn1, qfA) MAKE_QF(qn2, qn3, qfB) }
        f32x4 SA[18], SB[18];
        const int base0 = (q0 + 256 + qs) % 384;
        const LAS unsigned char* kb3 = (const LAS unsigned char*)(Kl + fr * KP + fq * 8); const LAS unsigned char* bb3 = (const LAS unsigned char*)(bl + 4 * fq - fr);
        const LAS unsigned char* vb3 = (const LAS unsigned char*)(VT + fr * VP + 4 * fq);
        {   bf16x8 kf[2][2]; f32x4 bi[2]; f32x4 bprev = {0.f, 0.f, 0.f, 0.f};
#define LDK(buf, kt) { const int sl_ = base0 + 16 * (kt) - ((base0 + 16 * (kt) >= 384) ? 384 : 0); const LAS unsigned char* kp_ = kb3 + sl_ * (KP * 2); \
                _Pragma("unroll") for (int ks = 0; ks < 2; ++ks) kf[buf][ks] = *(const LAS bf16x8*)(kp_ + ks * 64); \
                if ((kt) < 17) { _Pragma("unroll") for (int r = 0; r < 4; ++r) bi[buf][r] = *(const LAS float*)(bb3 + ((kt) * 16 + r) * 4); } }
            LDK(0, 0)
#pragma unroll
            for (int kt = 0; kt < 18; ++kt) {
                if (kt < 17) { LDK((kt + 1) & 1, kt + 1) }
                __builtin_amdgcn_sched_barrier(0);
                if (kt < 17) { f32x4 acc = bi[kt & 1];
                    acc = __builtin_amdgcn_mfma_f32_16x16x32_bf16(kf[kt & 1][0], qfA[0], acc, 0, 0, 0); acc = __builtin_amdgcn_mfma_f32_16x16x32_bf16(kf[kt & 1][1], qfA[1], acc, 0, 0, 0); SA[kt] = acc; }
                if (kt >= 1) { f32x4 acc = bprev;
                    acc = __builtin_amdgcn_mfma_f32_16x16x32_bf16(kf[kt & 1][0], qfB[0], acc, 0, 0, 0); acc = __builtin_amdgcn_mfma_f32_16x16x32_bf16(kf[kt & 1][1], qfB[1], acc, 0, 0, 0); SB[kt] = acc; }
                if (kt < 17) bprev = bi[kt & 1];
                __builtin_amdgcn_sched_barrier(0);
            }
#undef LDK
        }
        u32x2 vf[1][4][2];
#define LDV(buf, kp) { const int cl_ = base0 + 32 * (kp) - ((base0 + 32 * (kp) >= 384) ? 384 : 0); const LAS unsigned char* vp_ = vb3 + cl_ * 2; \
        _Pragma("unroll") for (int dt = 0; dt < 4; ++dt) { vf[buf][dt][0] = *(const LAS u32x2*)(vp_ + (dt * 16 * VP) * 2); vf[buf][dt][1] = *(const LAS u32x2*)(vp_ + (dt * 16 * VP + 16) * 2); } }
#pragma unroll
        for (int r = 0; r < 4; ++r) { if (4 * fq + r - fr < 0) { SA[0][r] = -1e30f; SB[1][r] = -1e30f; } if (4 * fq + r - fr > 0) { SA[16][r] = -1e30f; SB[17][r] = -1e30f; } }
        if (edge) {
#pragma unroll
            for (int kt = 0; kt < 18; ++kt)
#pragma unroll
                for (int r = 0; r < 4; ++r) { const int kpos = q0 - 128 + qs + kt * 16 + 4 * fq + r; if (kpos < 0 || kpos >= L) { if (kt < 17) SA[kt][r] = -1e30f; if (kt >= 1) SB[kt][r] = -1e30f; } } }
        float invA, invB;
        {   float mx = sink;
#pragma unroll
            for (int kt = 0; kt < 17; ++kt)
#pragma unroll
                for (int r = 0; r < 4; ++r) mx = fmaxf(mx, SA[kt][r]);
            mx = fmaxf(mx, __shfl_xor(mx, 16)); mx = fmaxf(mx, __shfl_xor(mx, 32));
            f32x4 sumv = {0.f, 0.f, 0.f, 0.f}; const f32x4 mxv = {mx, mx, mx, mx};
#pragma unroll
            for (int kt = 0; kt < 17; ++kt) { f32x4 d = SA[kt] - mxv;
#pragma unroll
                for (int r = 0; r < 4; ++r) d[r] = __builtin_amdgcn_exp2f(d[r]);
                SA[kt] = d; sumv += d; }
            float sum = (sumv[0] + sumv[1]) + (sumv[2] + sumv[3]);
            sum += __shfl_xor(sum, 16); sum += __shfl_xor(sum, 32); sum += __builtin_amdgcn_exp2f(sink - mx);
            invA = 1.0f / sum; SA[17] = (f32x4){0.f, 0.f, 0.f, 0.f}; }
        {   float mx = sink;
#pragma unroll
            for (int kt = 1; kt < 18; ++kt)
#pragma unroll
                for (int r = 0; r < 4; ++r) mx = fmaxf(mx, SB[kt][r]);
            mx = fmaxf(mx, __shfl_xor(mx, 16)); mx = fmaxf(mx, __shfl_xor(mx, 32));
            f32x4 sumv = {0.f, 0.f, 0.f, 0.f}; const f32x4 mxv = {mx, mx, mx, mx};
#pragma unroll
            for (int kt = 1; kt < 18; ++kt) { f32x4 d = SB[kt] - mxv;
#pragma unroll
                for (int r = 0; r < 4; ++r) d[r] = __builtin_amdgcn_exp2f(d[r]);
                SB[kt] = d; sumv += d; }
            float sum = (sumv[0] + sumv[1]) + (sumv[2] + sumv[3]);
            sum += __shfl_xor(sum, 16); sum += __shfl_xor(sum, 32); sum += __builtin_amdgcn_exp2f(sink - mx);
            invB = 1.0f / sum; SB[0] = (f32x4){0.f, 0.f, 0.f, 0.f}; }
        f32x4 OcA[4], OcB[4];
#pragma unroll
        for (int dt = 0; dt < 4; ++dt) { OcA[dt] = (f32x4){0.f, 0.f, 0.f, 0.f}; OcB[dt] = (f32x4){0.f, 0.f, 0.f, 0.f}; }
#pragma unroll
        for (int kp = 0; kp < 9; ++kp) {
            LDV(0, kp)
            u32x4 pa, pb_;
            pa.x = cvt_pk_bf16(SA[2 * kp][0], SA[2 * kp][1]); pa.y = cvt_pk_bf16(SA[2 * kp][2], SA[2 * kp][3]); pa.z = cvt_pk_bf16(SA[2 * kp + 1][0], SA[2 * kp + 1][1]); pa.w = cvt_pk_bf16(SA[2 * kp + 1][2], SA[2 * kp + 1][3]);
            pb_.x = cvt_pk_bf16(SB[2 * kp][0], SB[2 * kp][1]); pb_.y = cvt_pk_bf16(SB[2 * kp][2], SB[2 * kp][3]); pb_.z = cvt_pk_bf16(SB[2 * kp + 1][0], SB[2 * kp + 1][1]); pb_.w = cvt_pk_bf16(SB[2 * kp + 1][2], SB[2 * kp + 1][3]);
            const bf16x8 pA = __builtin_bit_cast(bf16x8, pa), pB = __builtin_bit_cast(bf16x8, pb_);
#pragma unroll
            for (int dt = 0; dt < 4; ++dt) { u32x4 av; av.x = vf[0][dt][0].x; av.y = vf[0][dt][0].y; av.z = vf[0][dt][1].x; av.w = vf[0][dt][1].y;
                const bf16x8 avf = __builtin_bit_cast(bf16x8, av);
                OcA[dt] = __builtin_amdgcn_mfma_f32_16x16x32_bf16(avf, pA, OcA[dt], 0, 0, 0); OcB[dt] = __builtin_amdgcn_mfma_f32_16x16x32_bf16(avf, pB, OcB[dt], 0, 0, 0); }
            __builtin_amdgcn_sched_barrier(0);
        }
#undef LDV
        { u32x4 o0, o1;
          o0.x = cvt_pk_bf16(OcA[0][0] * invA, OcA[0][1] * invA); o0.y = cvt_pk_bf16(OcA[0][2] * invA, OcA[0][3] * invA); o0.z = cvt_pk_bf16(OcA[1][0] * invA, OcA[1][1] * invA); o0.w = cvt_pk_bf16(OcA[1][2] * invA, OcA[1][3] * invA);
          o1.x = cvt_pk_bf16(OcA[2][0] * invA, OcA[2][1] * invA); o1.y = cvt_pk_bf16(OcA[2][2] * invA, OcA[2][3] * invA); o1.z = cvt_pk_bf16(OcA[3][0] * invA, OcA[3][1] * invA); o1.w = cvt_pk_bf16(OcA[3][2] * invA, OcA[3][3] * invA);
          bf16_t* op = O + (unsigned)(((unsigned)rowbase + q0 + qs + fr) * 1024u + H * 64 + 16 * fq); *(u32x4*)op = o0; *(u32x4*)(op + 8) = o1;
          o0.x = cvt_pk_bf16(OcB[0][0] * invB, OcB[0][1] * invB); o0.y = cvt_pk_bf16(OcB[0][2] * invB, OcB[0][3] * invB); o0.z = cvt_pk_bf16(OcB[1][0] * invB, OcB[1][1] * invB); o0.w = cvt_pk_bf16(OcB[1][2] * invB, OcB[1][3] * invB);
          o1.x = cvt_pk_bf16(OcB[2][0] * invB, OcB[2][1] * invB); o1.y = cvt_pk_bf16(OcB[2][2] * invB, OcB[2][3] * invB); o1.z = cvt_pk_bf16(OcB[3][0] * invB, OcB[3][1] * invB); o1.w = cvt_pk_bf16(OcB[3][2] * invB, OcB[3][3] * invB);
          op += 16 * 1024; *(u32x4*)op = o0; *(u32x4*)(op + 8) = o1; }
        if (pr == 0) { const bf16_t* qb2 = QKV + (unsigned)(((unsigned)rowbase + q0 + (w & 1) * 64 + 32 + fr) * 1536u + (kvh * 4 + (w >> 1)) * 64 + fq * 8);
            qn0 = *(const u32x4*)qb2; qn1 = *(const u32x4*)(qb2 + 32); qn2 = *(const u32x4*)(qb2 + 16 * 1536); qn3 = *(const u32x4*)(qb2 + 16 * 1536 + 32); }
    }
#undef MAKE_QF
    __syncthreads();
}

__device__ __forceinline__ int rel_bucket(int rel) {
    const int n = rel < 0 ? -rel : rel; int ret = rel > 0 ? 16 : 0;
    int large = 8; if (n >= 8) { const unsigned q = (unsigned)(n * n) >> 6; large = 8 + (31 - __builtin_clz(q)); } if (large > 15) large = 15;
    return ret + (n < 8 ? n : large);
}

#define XB_TMO      128
#define XB_XCNT(j)  (256  + 64 * (j))
#define XB_XSUB(j)  (1280 + 64 * (j))
#define XB_XGEN(j)  (2304 + 64 * (j))
#define XB_TOP      3328
#define XB_TOPGEN   3392
#define XCD_BAR_WORDS 3456
#define XB_SPIN_CAP (1u << 22)

__device__ __forceinline__ unsigned xb_ld(unsigned* p)              { return __hip_atomic_load(p, __ATOMIC_RELAXED, __HIP_MEMORY_SCOPE_AGENT); }
__device__ __forceinline__ unsigned xb_add(unsigned* p, unsigned v) { return __hip_atomic_fetch_add(p, v, __ATOMIC_RELAXED, __HIP_MEMORY_SCOPE_AGENT); }
__device__ __forceinline__ unsigned xb_xcc_id() { return (unsigned)__builtin_amdgcn_s_getreg((3 << 11) | 20) & 0xFu; }
#define XB_SPIN(cond, bar) do { unsigned _sp = 0; while (cond) { __builtin_amdgcn_s_sleep(1); \
    if ((++_sp & 255u) == 0u) { if (xb_ld(&(bar)[XB_TMO])) break; if (_sp > XB_SPIN_CAP) { atomicAdd(&(bar)[XB_TMO], 1u); break; } } } } while (0)

struct XcdBarrier {
    unsigned* bar; unsigned x;
    volatile LAS unsigned* st;
};

__device__ __forceinline__ XcdBarrier xcd_barrier_post(unsigned* bar, volatile LAS unsigned* st) {
    XcdBarrier b; b.bar = bar; b.x = xb_xcc_id(); b.st = st;
    if (threadIdx.x == 0) (void)xb_add(&bar[XB_XCNT(b.x)], 1u);
    return b;
}
__device__ __forceinline__ void xcd_barrier_complete(unsigned* bar, unsigned x, unsigned& nloc, unsigned& nx) {
    const unsigned G = gridDim.x * gridDim.y * gridDim.z;
    unsigned sum, cnt, mine, sp = 0u;
    for (;;) {
        sum = 0u; cnt = 0u; mine = 0u;
#pragma unroll
        for (unsigned j = 0; j < 16; ++j) { const unsigned c = xb_ld(&bar[XB_XCNT(j)]); sum += c; cnt += (c > 0u) ? 1u : 0u; mine = (j == x) ? c : mine; }
        if (sum == G) break;
        __builtin_amdgcn_s_sleep(1);
        if ((++sp & 255u) == 0u) { if (xb_ld(&bar[XB_TMO])) break; if (sp > XB_SPIN_CAP) { atomicAdd(&bar[XB_TMO], 1u); break; } }
    }
    nloc = mine > 0u ? mine : 1u; nx = cnt > 0u ? cnt : 1u;
}

__device__ __forceinline__ void xcd_barrier(const XcdBarrier& b) {
    asm volatile("s_waitcnt vmcnt(0)" ::: "memory");
    __syncthreads();
    if (threadIdx.x == 0) {
        unsigned* bar = b.bar;
        __builtin_amdgcn_s_waitcnt(0);
        unsigned nloc = b.st[0], nx = b.st[1];
        if (nloc == 0u) { xcd_barrier_complete(bar, b.x, nloc, nx); b.st[0] = nloc; b.st[1] = nx; }
        const unsigned old = xb_add(&bar[XB_XSUB(b.x)], 1u);
        const unsigned gen = old / nloc;
        if (old + 1u == (gen + 1u) * nloc) {
            __builtin_amdgcn_fence(__ATOMIC_RELEASE, "agent");
            asm volatile("s_waitcnt vmcnt(0)" ::: "memory");
            const unsigned og = xb_add(&bar[XB_TOP], 1u);
            const unsigned tg = og / nx;
            if (og + 1u == (tg + 1u) * nx) xb_add(&bar[XB_TOPGEN], 1u);
            else XB_SPIN(xb_ld(&bar[XB_TOPGEN]) == tg, bar);
            __builtin_amdgcn_fence(__ATOMIC_ACQUIRE, "agent");
            xb_add(&bar[XB_XGEN(b.x)], 1u);
            asm volatile("s_waitcnt vmcnt(0)" ::: "memory");
        } else {
            XB_SPIN(xb_ld(&bar[XB_XGEN(b.x)]) == gen, bar);
            __builtin_amdgcn_fence(__ATOMIC_ACQUIRE, "agent");
            asm volatile("s_waitcnt vmcnt(0)" ::: "memory");
        }
    }
    __syncthreads();
}

__global__ void __launch_bounds__(512, 2) fwd_kernel(Args a) {
    extern __shared__ __attribute__((aligned(16))) unsigned char lds[];
    cg::grid_group grid = cg::this_grid();
    LAS unsigned char* lds3 = (LAS unsigned char*)lds;
    const int G = gridDim.x, bx = blockIdx.x;
    unsigned char* ws = a.ws;
    volatile LAS unsigned* bst = (volatile LAS unsigned*)(lds3 + 131072 + 64);
    { const int t0 = fresh_tid(); if (t0 < 2) bst[t0] = 0u;
      if (bx == 0) for (int e = t0; e < XCD_BAR_WORDS; e += 512) ((unsigned*)(ws + WS_BAR))[e] = 0u; }
    __syncthreads();

    #ifndef NO_S5P
    if (bx < 32) s5_prep(a, bx, lds);
#endif
    {
        const int tid = fresh_tid(), lane = tid & 63, wave = tid >> 6, gw = bx * 8 + wave, NGW = G * 8;
        float* scr = (float*)(lds + wave * 16384);
        constexpr int I_IN = 16 * 48, I_GLU = 8 * 16, I_OUT = 16 * 32, I_QKV = 16 * 48, I_O = 16 * 32, I_G = 16 * 88, I_D = 44 * 32;
        constexpr int NITEMS = I_IN + I_GLU + I_OUT + I_QKV + I_O + 4 * I_G + 2 * I_D;
        for (int it = gw; it < NITEMS; it += NGW) {
            int r = it;
            if (r < I_IN) { transpose_item(a.in[4], 1024, 1536, (bf16_t*)(ws + WS_WIN), 0, scr, r, lane, a.in[2]); continue; } r -= I_IN;
            if (r < I_GLU) { transpose_item(a.in[13], 512, 512, (bf16_t*)(ws + WS_WGLU), 0, scr, r, lane); continue; } r -= I_GLU;
            if (r < I_OUT) { transpose_item(a.in[18], 1024, 1024, (bf16_t*)(ws + WS_WOUT), 0, scr, r, lane); continue; } r -= I_OUT;
            if (r < I_QKV) { transpose_item(a.in[19], 1024, 1536, (bf16_t*)(ws + WS_WQKV), 0, scr, r, lane, a.in[2] + DM); continue; } r -= I_QKV;
            if (r < I_O) { transpose_item(a.in[23], 1024, 1024, (bf16_t*)(ws + WS_WO), 0, scr, r, lane); continue; } r -= I_O;
            if (r < 4 * I_G) { const int l = r / (2 * I_G), rr = r % (2 * I_G), up = rr / I_G, item = rr % I_G;
                transpose_item(a.in[up ? 26 : 25] + (size_t)l * 1024 * DFF, 1024, DFF, (bf16_t*)(ws + (l ? WS_WGU1 : WS_WGU0)), up ? 2 : 1, scr, item, lane, a.in[3] + l * DM); continue; } r -= 4 * I_G;
            { const int l = r / I_D, item = r % I_D; transpose_item(a.in[27] + (size_t)l * DFF * 1024, DFF, 1024, (bf16_t*)(ws + (l ? WS_WD1 : WS_WD0)), 0, scr, item, lane); }
        }
        for (int e = bx * 512 + tid; e < 16 * 257; e += G * 512) { const int h = e / 257, rel = e % 257 - 128; ((float*)(ws + WS_BIAS))[e] = a.in[24][rel_bucket(rel) * 16 + h] * 1.4426950408889634f; }
        for (int e = bx * 512 + tid; e < 3 * MT; e += G * 512) ((float*)(ws + WS_SSQ))[e] = 0.f;
        rms_rows(a.in[0], a.in[1], a.in[2], (bf16_t*)(ws + WS_XB), (float*)(ws + WS_SSQ) + 3 * MT);
    }
    grid.sync();
    const XcdBarrier xbar = xcd_barrier_post((unsigned*)(ws + WS_BAR), bst);

    { constexpr int layer = 0;
        if constexpr (layer == 0) {
            { pg8::Gemm g{(const bf16_t*)(ws + WS_XB), (const bf16_t*)(ws + WS_WIN), 1024, 1024, 1024}; pg8::StaticOrder S; S.init(MT, 1536, G, bx);
              pg8::EpiIn E{(bf16_t*)(ws + WS_A2), (bf16_t*)(ws + WS_UB), (bf16_t*)(ws + WS_VB)};
              pg8::gemm_phase(lds3, g, S, E); }
            xcd_barrier(xbar);
            { pg8::Gemm g{(const bf16_t*)(ws + WS_A2), (const bf16_t*)(ws + WS_B1), 256, 512, 512}; pg8::GroupedOrder S{G, bx};
              pg8::EpiE E{(bf16_t*)(ws + WS_E)};
              pg8::gemm_phase(lds3, g, S, E); }
            __syncthreads();
#ifndef NO_SG
            sg_phase(a, lds);
#endif
            xcd_barrier(xbar);
            { const int tid_ = fresh_tid(); const int sub = tid_ >> 7, t = tid_ & 127; const int unit = sub * G + bx;
#ifndef NO_SCAN
              if (unit < 384) scan_unit(a, unit, t);
#endif
            }
            xcd_barrier(xbar);
            { pg8::Gemm g{(const bf16_t*)(ws + WS_A2), (const bf16_t*)(ws + WS_B3), 512, 512, 512}; pg8::GroupedOrder S{G, bx};
              pg8::EpiS3 E{(bf16_t*)(ws + WS_YG)};
              pg8::gemm_phase(lds3, g, S, E); }
            xcd_barrier(xbar);
            { pg8::Gemm g{(const bf16_t*)(ws + WS_YG), (const bf16_t*)(ws + WS_WGLU), 512, 512, 512}; pg8::StaticOrder S; S.init(MT, 512, G, bx);
              pg8::EpiGlu E{(const bf16_t*)(ws + WS_YG), a.in[14], (bf16_t*)(ws + WS_R1)};
              pg8::gemm_phase(lds3, g, S, E); }
            xcd_barrier(xbar);
        } else {
            { pg8::Gemm g{(const bf16_t*)(ws + WS_XB), (const bf16_t*)(ws + WS_WQKV), 1024, 1024, 1024}; pg8::StaticOrder S; S.init(MT, 1536, G, bx);
              pg8::EpiBf16 E{(bf16_t*)(ws + WS_R2), 1536, (const float*)(ws + WS_SSQ) + MT};
              pg8::gemm_phase(lds3, g, S, E); }
            xcd_barrier(xbar);
            { const int u_lo = (int)((long)bx * 2560 / G), u_hi = (int)((long)(bx + 1) * 2560 / G); int pst = -1, pqb = -2;
              for (int U = u_lo; U < u_hi; ++U) { int st, qb; if (U < 512) { st = U >> 5; qb = U & 31; } else { st = 16 + ((U - 512) >> 6); qb = (U - 512) & 63; }
                const int s = st >> 2, kvh = st & 3; const bool cont = (st == pst) && (qb == pqb + 1); pst = st; pqb = qb;
                attn_unit(a, s, qb, kvh, cont, lds); } }
            xcd_barrier(xbar);
        }
        { pg8::Gemm g{(const bf16_t*)(ws + WS_R1), (const bf16_t*)(ws + (layer ? WS_WO : WS_WOUT)), 1024, 1024, 1024}; pg8::StaticOrder S; S.init(MT, 1024, G, bx);
          if constexpr (layer == 0) { pg8::EpiRes<3> E{a.in[2], (const float*)(ws + WS_SSQ) + 3 * MT, nullptr, (bf16_t*)(ws + WS_XB), (float*)(ws + WS_SSQ)}; pg8::gemm_phase(lds3, g, S, E); }
          else { pg8::EpiRes<1> E{nullptr, nullptr, nullptr, (bf16_t*)(ws + WS_XB), (float*)(ws + WS_SSQ) + 2 * MT}; pg8::gemm_phase(lds3, g, S, E); } }
        xcd_barrier(xbar);
        { pg8::Gemm g{(const bf16_t*)(ws + WS_XB), (const bf16_t*)(ws + (layer ? WS_WGU1 : WS_WGU0)), 1024, 1024, 1024}; pg8::StaticOrder S; S.init(MT, NGU, G, bx);
          pg8::EpiSwiglu E{(bf16_t*)(ws + WS_R2), (const float*)(ws + WS_SSQ) + (layer ? 2 * MT : 0)};
          pg8::gemm_phase(lds3, g, S, E); }
        xcd_barrier(xbar);
        { pg8::Gemm g{(const bf16_t*)(ws + WS_R2), (const bf16_t*)(ws + (layer ? WS_WD1 : WS_WD0)), DFF, DFF, DFF}; pg8::StaticOrder S; S.init(MT, 1024, G, bx, true);
          if constexpr (layer == 0) { pg8::EpiRes<1> E{nullptr, nullptr, nullptr, (bf16_t*)(ws + WS_XB), (float*)(ws + WS_SSQ) + MT}; pg8::gemm_phase(lds3, g, S, E); xcd_barrier(xbar); }
          else { pg8::EpiRes<2> E{nullptr, nullptr, a.out, (bf16_t*)(ws + WS_XB), nullptr}; pg8::gemm_phase(lds3, g, S, E); } }
    }
    { constexpr int layer = 1;
        if constexpr (layer == 0) {
            { pg8::Gemm g{(const bf16_t*)(ws + WS_XB), (const bf16_t*)(ws + WS_WIN), 1024, 1024, 1024}; pg8::StaticOrder S; S.init(MT, 1536, G, bx);
              pg8::EpiIn E{(bf16_t*)(ws + WS_A2), (bf16_t*)(ws + WS_UB), (bf16_t*)(ws + WS_VB)};
              pg8::gemm_phase(lds3, g, S, E); }
            xcd_barrier(xbar);
            { pg8::Gemm g{(const bf16_t*)(ws + WS_A2), (const bf16_t*)(ws + WS_B1), 256, 512, 512}; pg8::GroupedOrder S{G, bx};
              pg8::EpiE E{(bf16_t*)(ws + WS_E)};
              pg8::gemm_phase(lds3, g, S, E); }
            __syncthreads();
#ifndef NO_SG
            sg_phase(a, lds);
#endif
            xcd_barrier(xbar);
            { const int tid_ = fresh_tid(); const int sub = tid_ >> 7, t = tid_ & 127; const int unit = sub * G + bx;
#ifndef NO_SCAN
              if (unit < 384) scan_unit(a, unit, t);
#endif
            }
            xcd_barrier(xbar);
            { pg8::Gemm g{(const bf16_t*)(ws + WS_A2), (const bf16_t*)(ws + WS_B3), 512, 512, 512}; pg8::GroupedOrder S{G, bx};
              pg8::EpiS3 E{(bf16_t*)(ws + WS_YG)};
              pg8::gemm_phase(lds3, g, S, E); }
            xcd_barrier(xbar);
            { pg8::Gemm g{(const bf16_t*)(ws + WS_YG), (const bf16_t*)(ws + WS_WGLU), 512, 512, 512}; pg8::StaticOrder S; S.init(MT, 512, G, bx);
              pg8::EpiGlu E{(const bf16_t*)(ws + WS_YG), a.in[14], (bf16_t*)(ws + WS_R1)};
              pg8::gemm_phase(lds3, g, S, E); }
            xcd_barrier(xbar);
        } else {
            { pg8::Gemm g{(const bf16_t*)(ws + WS_XB), (const bf16_t*)(ws + WS_WQKV), 1024, 1024, 1024}; pg8::StaticOrder S; S.init(MT, 1536, G, bx);
              pg8::EpiBf16 E{(bf16_t*)(ws + WS_R2), 1536, (const float*)(ws + WS_SSQ) + MT};
              pg8::gemm_phase(lds3, g, S, E); }
            xcd_barrier(xbar);
            { const int u_lo = (int)((long)bx * 2560 / G), u_hi = (int)((long)(bx + 1) * 2560 / G); int pst = -1, pqb = -2;
              for (int U = u_lo; U < u_hi; ++U) { int st, qb; if (U < 512) { st = U >> 5; qb = U & 31; } else { st = 16 + ((U - 512) >> 6); qb = (U - 512) & 63; }
                const int s = st >> 2, kvh = st & 3; const bool cont = (st == pst) && (qb == pqb + 1); pst = st; pqb = qb;
                attn_unit(a, s, qb, kvh, cont, lds); } }
            xcd_barrier(xbar);
        }
        { pg8::Gemm g{(const bf16_t*)(ws + WS_R1), (const bf16_t*)(ws + (layer ? WS_WO : WS_WOUT)), 1024, 1024, 1024}; pg8::StaticOrder S; S.init(MT, 1024, G, bx);
          if constexpr (layer == 0) { pg8::EpiRes<3> E{a.in[2], (const float*)(ws + WS_SSQ) + 3 * MT, nullptr, (bf16_t*)(ws + WS_XB), (float*)(ws + WS_SSQ)}; pg8::gemm_phase(lds3, g, S, E); }
          else { pg8::EpiRes<1> E{nullptr, nullptr, nullptr, (bf16_t*)(ws + WS_XB), (float*)(ws + WS_SSQ) + 2 * MT}; pg8::gemm_phase(lds3, g, S, E); } }
        xcd_barrier(xbar);
        { pg8::Gemm g{(const bf16_t*)(ws + WS_XB), (const bf16_t*)(ws + (layer ? WS_WGU1 : WS_WGU0)), 1024, 1024, 1024}; pg8::StaticOrder S; S.init(MT, NGU, G, bx);
          pg8::EpiSwiglu E{(bf16_t*)(ws + WS_R2), (const float*)(ws + WS_SSQ) + (layer ? 2 * MT : 0)};
          pg8::gemm_phase(lds3, g, S, E); }
        xcd_barrier(xbar);
        { pg8::Gemm g{(const bf16_t*)(ws + WS_R2), (const bf16_t*)(ws + (layer ? WS_WD1 : WS_WD0)), DFF, DFF, DFF}; pg8::StaticOrder S; S.init(MT, 1024, G, bx, true);
          if constexpr (layer == 0) { pg8::EpiRes<1> E{nullptr, nullptr, nullptr, (bf16_t*)(ws + WS_XB), (float*)(ws + WS_SSQ) + MT}; pg8::gemm_phase(lds3, g, S, E); xcd_barrier(xbar); }
          else { pg8::EpiRes<2> E{nullptr, nullptr, a.out, (bf16_t*)(ws + WS_XB), nullptr}; pg8::gemm_phase(lds3, g, S, E); } }
    }
}

extern "C" void kernel_launch(void* const* d_in, const int* in_sizes, int n_in, void* d_out, int out_size, void* d_ws, size_t ws_size, hipStream_t stream) {
    static int grid = 0;
    if (grid == 0) {
        if (n_in != 28 || out_size != MT * DM || ws_size < WS_END) { fprintf(stderr, "kernel_launch: unexpected shapes (n_in %d out %d ws %zu)\n", n_in, out_size, ws_size); grid = -1; return; }
        int dev = 0, cus = 0, per_cu = 0;
        hipGetDevice(&dev); hipDeviceGetAttribute(&cus, hipDeviceAttributeMultiprocessorCount, dev);
        hipFuncSetAttribute((const void*)fwd_kernel, hipFuncAttributeMaxDynamicSharedMemorySize, LDS_BYTES);
        hipOccupancyMaxActiveBlocksPerMultiprocessor(&per_cu, (const void*)fwd_kernel, 512, LDS_BYTES);
        if (per_cu < 1) per_cu = 1;
        grid = cus * per_cu;
        (void)hipGetLastError();
    }
    if (grid < 0) return;
    Args a{};
    for (int i = 0; i < 28; ++i) a.in[i] = (const float*)d_in[i];
    a.out = (float*)d_out; a.ws = (unsigned char*)d_ws;
    void* args[] = {&a};
    hipError_t e = hipLaunchCooperativeKernel((const void*)fwd_kernel, dim3(grid), dim3(512), args, LDS_BYTES, stream);
    if (e != hipSuccess) fprintf(stderr, "cooperative launch failed: %s (grid %d)\n", hipGetErrorString(e), grid);
}
```

```cpp
#include <hip/hip_runtime.h>
#include <hip/hip_cooperative_groups.h>
#include <cstdio>
#include <cstdint>
namespace cg = cooperative_groups;

#define LAS __attribute__((address_space(3)))
typedef unsigned short bf16_t;
typedef short bf16x8 __attribute__((ext_vector_type(8)));
typedef float f32x4 __attribute__((ext_vector_type(4)));
typedef float f32x2 __attribute__((ext_vector_type(2)));
typedef unsigned u32x4 __attribute__((ext_vector_type(4)));
typedef unsigned u32x2 __attribute__((ext_vector_type(2)));

constexpr int MP = 16384, MT = 81920;
constexpr int DM = 1024, DFF = 2816, NGU = 2 * DFF;
constexpr int NCH = MT / 16;
constexpr float EPS = 1e-6f;

constexpr size_t MiB = 1u << 20;
constexpr size_t WS_WIN = 0, WS_WQKV = 3 * MiB, WS_WOUT = 6 * MiB, WS_WO = 8 * MiB, WS_WGLU = 10 * MiB;
constexpr size_t WS_WGU0 = 11 * MiB, WS_WGU1 = 22 * MiB, WS_WD0 = 33 * MiB, WS_WD1 = 39 * MiB;
constexpr size_t WS_B1 = 45 * MiB, WS_B3 = 53 * MiB, WS_AT = 61 * MiB, WS_BIAS = 61 * MiB + 65536;
constexpr size_t WS_R1 = 64 * MiB;
constexpr size_t WS_R2 = 224 * MiB;
constexpr size_t WS_A2 = WS_R2, WS_UB = WS_R2 + 160 * MiB, WS_VB = WS_R2 + 240 * MiB, WS_E = WS_R2 + 320 * MiB;
constexpr size_t WS_BAR = 63 * MiB + 512 * 1024;
constexpr size_t WS_SSQ = 62 * MiB;
constexpr size_t WS_XB = WS_R2 + 480 * MiB;
constexpr size_t WS_YG = WS_E + 80 * MiB;
constexpr size_t WS_END = WS_XB + 160 * MiB;

__device__ __forceinline__ int fresh_tid() { int t = threadIdx.x; asm volatile("" : "+v"(t)); return t; }
__device__ __forceinline__ unsigned cvt_pk_bf16(float lo, float hi) { unsigned r; asm volatile("v_cvt_pk_bf16_f32 %0, %1, %2" : "=v"(r) : "v"(lo), "v"(hi)); return r; }
__device__ __forceinline__ float bf_lo(unsigned w) { return __uint_as_float(w << 16); }
__device__ __forceinline__ float bf_hi(unsigned w) { return __uint_as_float(w & 0xffff0000u); }
__device__ __forceinline__ float sigmoid_f(float x) { return __builtin_amdgcn_rcpf(1.0f + __expf(-x)); }
__device__ __forceinline__ float gelu_f(float v) { const float t = 1.5957691216057308f * (v + 0.044715f * v * v * v); return v * sigmoid_f(t); }

namespace pg8 {
constexpr int BM = 256, BK = 64, HALF = 128, HTB = HALF * BK * 2, STAGE_BYTES = 8 * HTB, NXCD = 8, WGM = 4;
__host__ __device__ __forceinline__ int lds_byte(int r, int c) { const int st = (r >> 4) * 2 + (c >> 5), rr = r & 15, cc = c & 31, ob = rr * 64 + cc * 2; return st * 1024 + (ob ^ (((ob >> 9) & 1) << 5)); }
__host__ __device__ __forceinline__ void stage_rc(int b, int& R, int& C) { const int st = b / 1024, sb = b % 1024, swz = sb ^ (((sb >> 9) & 1) << 5); R = (st >> 1) * 16 + swz / 64; C = (st & 1) * 32 + (swz % 64) / 2; }
__host__ __device__ __forceinline__ int perm32(int rho) { const int n = rho >> 4, i = rho & 15; return 8 * (i >> 2) + 4 * n + (i & 3); }

struct Unit { int pm, pn; };
struct Gemm { const bf16_t* A; const bf16_t* Bt; int K, lda, ldb; unsigned kstepA, tstepA; int amode; };

struct StaticOrder {
    int nM, nN, nwg, G, c; bool rev;
    __device__ void init(int M, int N, int G_, int c_, bool rev_ = false) { nM = M / BM; nN = N / BM; nwg = nM * nN; G = G_; c = c_; rev = rev_; }
    __device__ bool next(int i, Unit& u) const {
        const long L = (long)i * G + c; if (L >= nwg) return false;
        int wgid = (int)L; { const int q = nwg / NXCD, r = nwg % NXCD, xcd = wgid % NXCD, off = wgid / NXCD; wgid = (xcd < r ? xcd * (q + 1) : r * (q + 1) + (xcd - r) * q) + off; }
        const int nig = WGM * nN, gid = wgid / nig, fm = gid * WGM, gsz = (nM - fm) < WGM ? (nM - fm) : WGM;
        u.pm = fm + ((wgid % nig) % gsz); u.pn = (wgid % nig) / gsz; if (rev) u.pm = nM - 1 - u.pm; return true;
    }
};
struct GroupedOrder {
    int G, c;
    __device__ bool next(int i, Unit& u) const { const int L = i * G + c; if (L >= 640) return false; u.pm = L; u.pn = L / 20; return true; }
};

template <class Epi, class Sched>
__device__ __forceinline__ void gemm_phase(LAS unsigned char* lds, const Gemm g, const Sched& S, const Epi& E) {
    const int tid = fresh_tid(), wid = __builtin_amdgcn_readfirstlane(tid >> 6), lane = tid & 63, wr = wid >> 2, wc = wid & 3, fr = lane & 15, fq = lane >> 4;
    const int K = g.K, nt = K / BK;
    unsigned voffA[2], voffB[2];
#pragma unroll
    for (int i = 0; i < 2; ++i) { int R, C; stage_rc(tid * 16 + i * 8192, R, C); const int Rb = Epi::PERM ? ((R & ~31) + perm32(R & 31)) : R;
        voffA[i] = (unsigned)(R * g.lda + (g.amode ? ((C >> 4) * (NCH * 256) + (C & 15)) : C)) * 2u; voffB[i] = (unsigned)(Rb * g.ldb + C) * 2u; }
    const size_t kstep = (size_t)(BK * 2); const size_t kA = g.kstepA ? (size_t)g.kstepA : kstep;
    const size_t hA = (size_t)HALF * g.lda * 2, hB = (size_t)HALF * g.ldb * 2;
    const size_t tA = g.tstepA ? (size_t)g.tstepA : 2 * hA, tB = 2 * hB;
    const unsigned ldsw = (unsigned)wid * 1024u;
    const int aoff = lds_byte(wr * 64 + fr, fq * 8), boff = lds_byte(wc * 32 + fr, fq * 8);
#define PG8_SA(b, h) (((b) * 2 + (h)) * HTB)
#define PG8_SB(b, h) ((4 + (b) * 2 + (h)) * HTB)
#define PG8_STAGE(bufoff, gbase, voff) do { _Pragma("unroll") for (int _i = 0; _i < 2; ++_i) \
        __builtin_amdgcn_global_load_lds((const unsigned*)((const char*)(gbase) + (voff)[_i]), (LAS unsigned*)(lds + (bufoff) + ldsw + _i * 8192), 16, 0, 0); } while (0)
#define PG8_LDA(dst, b, h) do { _Pragma("unroll") for (int m = 0; m < 4; ++m) _Pragma("unroll") for (int k = 0; k < 2; ++k) dst[m][k] = *(const LAS bf16x8*)(lds + PG8_SA(b, h) + aoff + m * 2048 + k * 1024); } while (0)
#define PG8_LDB(dst, b, h) do { _Pragma("unroll") for (int n = 0; n < 2; ++n) _Pragma("unroll") for (int k = 0; k < 2; ++k) dst[n][k] = *(const LAS bf16x8*)(lds + PG8_SB(b, h) + boff + n * 2048 + k * 1024); } while (0)
#define PG8_MMA(ai, bj, At, Bt) do { __builtin_amdgcn_s_setprio(1); _Pragma("unroll") for (int m = 0; m < 4; ++m) _Pragma("unroll") for (int n = 0; n < 2; ++n) _Pragma("unroll") for (int k = 0; k < 2; ++k) \
        acc[ai][bj][m][n] = __builtin_amdgcn_mfma_f32_16x16x32_bf16(Bt[n][k], At[m][k], acc[ai][bj][m][n], 0, 0, 0); __builtin_amdgcn_s_setprio(0); } while (0)
#define PG8_WAIT_V(n) asm volatile("s_waitcnt vmcnt(" #n ")" ::: "memory")
#define PG8_WAIT_L(n) asm volatile("s_waitcnt lgkmcnt(" #n ")" ::: "memory")
#define PG8_BAR __builtin_amdgcn_s_barrier()
#define PG8_SCHED __builtin_amdgcn_sched_barrier(0)
    Unit cur, nxt; int ui = 0;
    if (!S.next(0, cur)) return;
    f32x4 acc[2][2][4][2];
#pragma unroll
    for (int a = 0; a < 2; ++a)
#pragma unroll
        for (int b = 0; b < 2; ++b)
#pragma unroll
            for (int m = 0; m < 4; ++m)
#pragma unroll
                for (int n = 0; n < 2; ++n) acc[a][b][m][n] = (f32x4){0.f, 0.f, 0.f, 0.f};
    bf16x8 At[4][2], B0[2][2], B1[2][2];
    const char* cA = (const char*)g.A + (size_t)cur.pm * tA; const char* cB = (const char*)g.Bt + (size_t)cur.pn * tB;
    PG8_STAGE(PG8_SB(0, 0), cB, voffB); PG8_STAGE(PG8_SB(0, 1), cB + hB, voffB); PG8_STAGE(PG8_SA(0, 0), cA, voffA); PG8_STAGE(PG8_SA(0, 1), cA + hA, voffA);
    if (wr == 1) PG8_BAR;
    PG8_WAIT_V(2); PG8_BAR;
    PG8_STAGE(PG8_SB(1, 0), cB + kstep, voffB); PG8_STAGE(PG8_SA(1, 0), cA + kA, voffA); PG8_STAGE(PG8_SB(1, 1), cB + hB + kstep, voffB);
    PG8_WAIT_V(6); PG8_BAR;
    for (;;) {
        const bool has_next = S.next(ui + 1, nxt);
        const char* nA = has_next ? (const char*)g.A + (size_t)nxt.pm * tA : cA; const char* nB = has_next ? (const char*)g.Bt + (size_t)nxt.pn * tB : cB;
        for (int t = 0; t < nt; t += 2) {
            const bool last = (t == nt - 2);
            const char* a1 = cA + (size_t)(t + 1) * kA;
            const char* a2 = last ? nA : cA + (size_t)(t + 2) * kA; const char* b2 = last ? nB : cB + (size_t)(t + 2) * kstep;
            const char* a3 = a2 + kA; const char* b3 = b2 + kstep;
            PG8_LDB(B0, 0, 0); PG8_LDB(B1, 0, 1); PG8_SCHED; PG8_LDA(At, 0, 0); PG8_STAGE(PG8_SA(1, 1), a1 + hA, voffA);
            PG8_WAIT_V(8); PG8_WAIT_L(0); PG8_BAR; PG8_MMA(0, 0, At, B0); PG8_MMA(0, 1, At, B1); PG8_BAR; PG8_SCHED;
            PG8_LDA(At, 0, 1); PG8_STAGE(PG8_SB(0, 0), b2, voffB); PG8_STAGE(PG8_SB(0, 1), b2 + hB, voffB); PG8_STAGE(PG8_SA(0, 0), a2, voffA);
            PG8_WAIT_V(8); PG8_WAIT_L(0); PG8_BAR; PG8_MMA(1, 0, At, B0); PG8_MMA(1, 1, At, B1); PG8_BAR; PG8_SCHED;
            PG8_LDB(B0, 1, 0); PG8_LDB(B1, 1, 1); PG8_SCHED; PG8_LDA(At, 1, 0); PG8_STAGE(PG8_SA(0, 1), a2 + hA, voffA);
            PG8_WAIT_V(8); PG8_WAIT_L(0); PG8_BAR; PG8_MMA(0, 0, At, B0); PG8_MMA(0, 1, At, B1); PG8_BAR; PG8_SCHED;
            PG8_LDA(At, 1, 1); PG8_STAGE(PG8_SB(1, 0), b3, voffB); PG8_STAGE(PG8_SB(1, 1), b3 + hB, voffB); PG8_STAGE(PG8_SA(1, 0), a3, voffA);
            PG8_WAIT_V(8); PG8_WAIT_L(0); PG8_BAR; PG8_MMA(1, 0, At, B0); PG8_MMA(1, 1, At, B1); PG8_BAR; PG8_SCHED;
        }
        if (wr == 0) PG8_BAR;
        E(acc, cur, wr, wc, fr, fq);
        if (!has_next) break;
#pragma unroll
        for (int a = 0; a < 2; ++a)
#pragma unroll
            for (int b = 0; b < 2; ++b)
#pragma unroll
                for (int m = 0; m < 4; ++m)
#pragma unroll
                    for (int n = 0; n < 2; ++n) acc[a][b][m][n] = (f32x4){0.f, 0.f, 0.f, 0.f};
        cur = nxt; cA = nA; cB = nB; ++ui;
        if (wr == 1) PG8_BAR;
    }
    PG8_WAIT_V(0);
    PG8_BAR;
#undef PG8_SA
#undef PG8_SB
#undef PG8_STAGE
#undef PG8_LDA
#undef PG8_LDB
#undef PG8_MMA
#undef PG8_WAIT_V
#undef PG8_WAIT_L
#undef PG8_BAR
#undef PG8_SCHED
}

typedef f32x4 Acc[2][2][4][2];

struct EpiIn {
    static constexpr bool PERM = true;
    bf16_t* A2; bf16_t* UB; bf16_t* VB;
    __device__ __forceinline__ void operator()(const Acc& acc, const Unit& u, int wr, int wc, int fr, int fq) const {
        const int row0 = u.pm * BM + wr * 64 + fr; const int part = u.pn >> 1;
#pragma unroll
        for (int ai = 0; ai < 2; ++ai)
#pragma unroll
            for (int m = 0; m < 4; ++m) { const int row = row0 + ai * HALF + m * 16;
#pragma unroll
                for (int bj = 0; bj < 2; ++bj) { const int col = u.pn * BM + bj * HALF + wc * 32 + 8 * fq;
                    f32x4 v0 = acc[ai][bj][m][0], v1 = acc[ai][bj][m][1]; bf16_t* dst;
                    if (part == 0) { const int g = col >> 4, h0 = col & 15, bc = row >> 4, j = row & 15; dst = A2 + ((size_t)(g * NCH + bc) * 512 + j * 16 + h0); }
                    else { for (int e = 0; e < 4; ++e) { v0[e] = gelu_f(v0[e]); v1[e] = gelu_f(v1[e]); } dst = (part == 1 ? UB : VB) + (size_t)row * 512 + (col - 512 * part); }
                    u32x4 w; w.x = cvt_pk_bf16(v0[0], v0[1]); w.y = cvt_pk_bf16(v0[2], v0[3]); w.z = cvt_pk_bf16(v1[0], v1[1]); w.w = cvt_pk_bf16(v1[2], v1[3]);
                    *(u32x4*)dst = w; } }
    }
};
struct EpiE {
    static constexpr bool PERM = false;
    bf16_t* E;
    __device__ __forceinline__ void operator()(const Acc& acc, const Unit& u, int wr, int wc, int fr, int fq) const {
#pragma unroll
        for (int ai = 0; ai < 2; ++ai)
#pragma unroll
            for (int m = 0; m < 4; ++m) { bf16_t* rp = E + (size_t)(u.pm * BM + ai * HALF + wr * 64 + m * 16 + fr) * 256 + wc * 32 + 4 * fq;
#pragma unroll
                for (int bj = 0; bj < 2; ++bj)
#pragma unroll
                    for (int n = 0; n < 2; ++n) { const f32x4 v = acc[ai][bj][m][n]; u32x2 w; w.x = cvt_pk_bf16(v[0], v[1]); w.y = cvt_pk_bf16(v[2], v[3]); *(u32x2*)(rp + bj * HALF + n * 16) = w; } }
    }
};
struct EpiS3 {
    static constexpr bool PERM = true;
    bf16_t* YG;
    __device__ __forceinline__ void operator()(const Acc& acc, const Unit& u, int wr, int wc, int fr, int fq) const {
        const int g = u.pn;
#pragma unroll
        for (int ai = 0; ai < 2; ++ai)
#pragma unroll
            for (int m = 0; m < 4; ++m) { const int bc = u.pm * BM + ai * HALF + wr * 64 + m * 16 + fr - g * NCH;
#pragma unroll
                for (int bj = 0; bj < 2; ++bj) { const int n0 = bj * HALF + wc * 32 + 8 * fq, i = n0 >> 4, hp = n0 & 15;
                    f32x4 v0 = acc[ai][bj][m][0], v1 = acc[ai][bj][m][1];
                    for (int e = 0; e < 4; ++e) { v0[e] = gelu_f(v0[e]); v1[e] = gelu_f(v1[e]); }
                    u32x4 w; w.x = cvt_pk_bf16(v0[0], v0[1]); w.y = cvt_pk_bf16(v0[2], v0[3]); w.z = cvt_pk_bf16(v1[0], v1[1]); w.w = cvt_pk_bf16(v1[2], v1[3]);
                    *(u32x4*)(YG + (size_t)(g * NCH + bc) * 256 + n0) = w; } }
    }
};
struct EpiGlu {
    static constexpr bool PERM = true;
    const bf16_t* YG; const float* bias; bf16_t* YAB;
    __device__ __forceinline__ void operator()(const Acc& acc, const Unit& u, int wr, int wc, int fr, int fq) const {
        const int row0 = u.pm * BM + wr * 64 + fr;
#pragma unroll
        for (int ai = 0; ai < 2; ++ai)
#pragma unroll
            for (int m = 0; m < 4; ++m) { const int row = row0 + ai * HALF + m * 16;
#pragma unroll
                for (int bj = 0; bj < 2; ++bj) { const int col = u.pn * BM + bj * HALF + wc * 32 + 8 * fq;
                    const u32x4 yv = *(const u32x4*)(YG + (size_t)(col >> 4) * (NCH * 256) + (size_t)row * 16 + (col & 15));
                    const f32x4 b0 = *(const f32x4*)(bias + col), b1 = *(const f32x4*)(bias + col + 4);
                    const f32x4 v0 = acc[ai][bj][m][0] + b0, v1 = acc[ai][bj][m][1] + b1;
                    u32x4 w;
                    w.x = cvt_pk_bf16(bf_lo(yv.x) * sigmoid_f(v0[0]), bf_hi(yv.x) * sigmoid_f(v0[1]));
                    w.y = cvt_pk_bf16(bf_lo(yv.y) * sigmoid_f(v0[2]), bf_hi(yv.y) * sigmoid_f(v0[3]));
                    w.z = cvt_pk_bf16(bf_lo(yv.z) * sigmoid_f(v1[0]), bf_hi(yv.z) * sigmoid_f(v1[1]));
                    w.w = cvt_pk_bf16(bf_lo(yv.w) * sigmoid_f(v1[2]), bf_hi(yv.w) * sigmoid_f(v1[3]));
                    *(u32x4*)(YAB + (size_t)row * 1024 + col) = w; } }
    }
};
template <int MODE> struct EpiRes {
    static constexpr bool PERM = true;
    const float* base0; const float* base1; float* out; bf16_t* XB; float* ssq;
    __device__ __forceinline__ void operator()(const Acc& acc, const Unit& u, int wr, int wc, int fr, int fq) const {
        const int row0 = u.pm * BM + wr * 64 + fr; const int col0 = u.pn * BM + wc * 32 + 8 * fq;
        const float* bp = (MODE == 0) ? ((u.pm < MP / BM) ? base0 : base1) : nullptr;
#pragma unroll
        for (int ai = 0; ai < 2; ++ai) {
            f32x4 bv[4][2][2];
#pragma unroll
            for (int m = 0; m < 4; ++m) { const size_t off = (size_t)(row0 + ai * HALF + m * 16) * DM + col0;
#pragma unroll
                for (int bj = 0; bj < 2; ++bj) {
                    if (MODE == 0) { bv[m][bj][0] = *(const f32x4*)(bp + off + bj * HALF); bv[m][bj][1] = *(const f32x4*)(bp + off + bj * HALF + 4); }
                    else if (MODE == 3) { const u32x4 xv = *(const u32x4*)(XB + off + bj * HALF); const float rn = sqrtf(base1[row0 + ai * HALF + m * 16] * (1.f / DM) + EPS);
                        bv[m][bj][0] = (f32x4){bf_lo(xv.x), bf_hi(xv.x), bf_lo(xv.y), bf_hi(xv.y)} * rn; bv[m][bj][1] = (f32x4){bf_lo(xv.z), bf_hi(xv.z), bf_lo(xv.w), bf_hi(xv.w)} * rn; }
                    else { const u32x4 xv = *(const u32x4*)(XB + off + bj * HALF); bv[m][bj][0] = (f32x4){bf_lo(xv.x), bf_hi(xv.x), bf_lo(xv.y), bf_hi(xv.y)}; bv[m][bj][1] = (f32x4){bf_lo(xv.z), bf_hi(xv.z), bf_lo(xv.w), bf_hi(xv.w)}; } } }
            asm volatile("" ::: "memory");
#pragma unroll
            for (int m = 0; m < 4; ++m) { const int row = row0 + ai * HALF + m * 16; const size_t off = (size_t)row * DM + col0; float sq = 0.f;
#pragma unroll
                for (int bj = 0; bj < 2; ++bj) {
                    const f32x4 o0 = bv[m][bj][0] + acc[ai][bj][m][0], o1 = bv[m][bj][1] + acc[ai][bj][m][1];
                    if (MODE == 2) { *(f32x4*)(out + off + bj * HALF) = o0; *(f32x4*)(out + off + bj * HALF + 4) = o1; }
                    else { sq += ((o0[0] * o0[0] + o0[1] * o0[1]) + (o0[2] * o0[2] + o0[3] * o0[3])) + ((o1[0] * o1[0] + o1[1] * o1[1]) + (o1[2] * o1[2] + o1[3] * o1[3]));
                        u32x4 w; w.x = cvt_pk_bf16(o0[0], o0[1]); w.y = cvt_pk_bf16(o0[2], o0[3]); w.z = cvt_pk_bf16(o1[0], o1[1]); w.w = cvt_pk_bf16(o1[2], o1[3]); *(u32x4*)(XB + off + bj * HALF) = w; } }
                if (MODE != 2) { sq += __shfl_xor(sq, 16); sq += __shfl_xor(sq, 32); if (fq == 0) unsafeAtomicAdd(ssq + row, sq); } }
            asm volatile("" ::: "memory"); }
    }
};
struct EpiSwiglu {
    static constexpr bool PERM = true;
    bf16_t* HB; const float* ssq;
    __device__ __forceinline__ void operator()(const Acc& acc, const Unit& u, int wr, int wc, int fr, int fq) const {
        const int row0 = u.pm * BM + wr * 64 + fr;
#pragma unroll
        for (int ai = 0; ai < 2; ++ai)
#pragma unroll
            for (int m = 0; m < 4; ++m) { const int row = row0 + ai * HALF + m * 16; bf16_t* rp = HB + (size_t)row * DFF + u.pn * HALF + wc * 32 + 8 * fq;
                const float rstd = rsqrtf(ssq[row] * (1.f / DM) + EPS);
                u32x4 w;
#pragma unroll
                for (int bj = 0; bj < 2; ++bj) { const f32x4 gt = acc[ai][bj][m][0] * rstd, up = acc[ai][bj][m][1] * rstd;
                    f32x4 e = gt * (-1.4426950408889634f);
#pragma unroll
                    for (int q = 0; q < 4; ++q) e[q] = __builtin_amdgcn_exp2f(e[q]);
                    e = e + 1.0f;
#pragma unroll
                    for (int q = 0; q < 4; ++q) e[q] = __builtin_amdgcn_rcpf(e[q]);
                    const f32x4 o = gt * e * up;
                    if (bj == 0) { w.x = cvt_pk_bf16(o[0], o[1]); w.y = cvt_pk_bf16(o[2], o[3]); } else { w.z = cvt_pk_bf16(o[0], o[1]); w.w = cvt_pk_bf16(o[2], o[3]); } }
                *(u32x4*)rp = w; }
    }
};
struct EpiBf16 {
    static constexpr bool PERM = true;
    bf16_t* O; int ldc; const float* ssq;
    __device__ __forceinline__ void operator()(const Acc& acc, const Unit& u, int wr, int wc, int fr, int fq) const {
        const int row0 = u.pm * BM + wr * 64 + fr; const int col0 = u.pn * BM + wc * 32 + 8 * fq;
#pragma unroll
        for (int ai = 0; ai < 2; ++ai)
#pragma unroll
            for (int m = 0; m < 4; ++m) { const int row = row0 + ai * HALF + m * 16; bf16_t* rp = O + (size_t)row * ldc + col0;
                const float rstd = rsqrtf(ssq[row] * (1.f / DM) + EPS);
#pragma unroll
                for (int bj = 0; bj < 2; ++bj) { const f32x4 v0 = acc[ai][bj][m][0] * rstd, v1 = acc[ai][bj][m][1] * rstd;
                    u32x4 w; w.x = cvt_pk_bf16(v0[0], v0[1]); w.y = cvt_pk_bf16(v0[2], v0[3]); w.z = cvt_pk_bf16(v1[0], v1[1]); w.w = cvt_pk_bf16(v1[2], v1[3]);
                    *(u32x4*)(rp + bj * HALF) = w; } }
    }
};
}

constexpr int LDS_BYTES = 147456;
struct Args { const float* in[28]; float* out; unsigned char* ws; };

__device__ __forceinline__ float wave_sum(float v) {
#pragma unroll
    for (int o = 1; o < 64; o <<= 1) v += __shfl_xor(v, o);
    return v;
}

__device__ __forceinline__ void transpose_item(const float* W, int K, int N, bf16_t* WT, int mode, float* scr, int item, int lane, const float* ksc = nullptr) {
    const int nblk = N / 32, kb = item / nblk, nb = item % nblk, k0 = 64 * kb, n0 = 32 * nb;
#pragma unroll 8
    for (int i = 0; i < 32; ++i) { const int kk = 2 * i + (lane >> 5); const float sc = ksc ? ksc[k0 + kk] : 1.0f; scr[kk * 33 + (lane & 31)] = W[(size_t)(k0 + kk) * N + n0 + (lane & 31)] * sc; }
    asm volatile("s_waitcnt lgkmcnt(0)" ::: "memory");
    const int c = lane & 7;
#pragma unroll
    for (int j = 0; j < 4; ++j) { const int nl = (lane >> 3) + 8 * j; const float* s = scr + (8 * c) * 33 + nl; const int n = n0 + nl;
        const int row = mode == 0 ? n : (256 * (n >> 7) + 128 * ((n >> 2) & 1) + 32 * ((n >> 5) & 3) + 8 * ((n >> 3) & 3) + (mode == 2 ? 4 : 0) + (n & 3));
        u32x4 o; o.x = cvt_pk_bf16(s[0 * 33], s[1 * 33]); o.y = cvt_pk_bf16(s[2 * 33], s[3 * 33]); o.z = cvt_pk_bf16(s[4 * 33], s[5 * 33]); o.w = cvt_pk_bf16(s[6 * 33], s[7 * 33]);
        *(u32x4*)(WT + (size_t)row * K + k0 + 8 * c) = o; }
    asm volatile("s_waitcnt lgkmcnt(0)" ::: "memory");
}

__device__ __forceinline__ void rms_rows(const float* src0, const float* src1, const float* gw_, bf16_t* XN, float* ssq) {
    if (blockIdx.x < 32) return;
    const int tid = fresh_tid(), lane = tid & 63, gw = (blockIdx.x - 32) * 8 + (tid >> 6), NGW = (gridDim.x - 32) * 8;
    int m = gw; f32x4 v[4];
    if (m < MT) { const f32x4* xr = (const f32x4*)((m < MP) ? src0 + (size_t)m * DM : src1 + (size_t)(m - MP) * DM) + lane;
#pragma unroll
        for (int j = 0; j < 4; ++j) v[j] = __builtin_nontemporal_load(xr + 64 * j); }
    for (; m < MT; m += NGW) {
        const int m2 = m + NGW; f32x4 nv[4];
        if (m2 < MT) { const f32x4* xr = (const f32x4*)((m2 < MP) ? src0 + (size_t)m2 * DM : src1 + (size_t)(m2 - MP) * DM) + lane;
#pragma unroll
            for (int j = 0; j < 4; ++j) nv[j] = __builtin_nontemporal_load(xr + 64 * j); }
        float s = 0.f;
#pragma unroll
        for (int j = 0; j < 4; ++j) s += (v[j].x * v[j].x + v[j].y * v[j].y) + (v[j].z * v[j].z + v[j].w * v[j].w);
        s = wave_sum(s); if (lane == 0) ssq[m] = s;
        const float rstd = rsqrtf(s * (1.f / DM) + EPS);
        u32x2* o8 = (u32x2*)(XN + (size_t)m * DM) + lane;
#pragma unroll
        for (int j = 0; j < 4; ++j) { u32x2 w; w.x = cvt_pk_bf16(v[j].x * rstd, v[j].y * rstd); w.y = cvt_pk_bf16(v[j].z * rstd, v[j].w * rstd); o8[64 * j] = w; }
        if (m2 < MT) {
#pragma unroll
            for (int j = 0; j < 4; ++j) v[j] = nv[j]; }
    }
}

__device__ __forceinline__ void s5_prep(const Args& a, int g, unsigned char* lds) {
    const int tid = fresh_tid();
    f32x2* apow = (f32x2*)lds;
    f32x2* bbar = apow + 2 * 17 * 64;
    f32x2* zt = bbar + 2 * 64 * 16;
    float* kmat = (float*)(zt + 128);
    const float* lam_re = a.in[5]; const float* lam_im = a.in[6]; const float* log_dt = a.in[7];
    const float* b_re = a.in[8]; const float* b_im = a.in[9]; const float* c_re = a.in[10]; const float* c_im = a.in[11]; const float* d_skip = a.in[12];
    bf16_t* B1 = (bf16_t*)(a.ws + WS_B1) + (size_t)g * 256 * 512;
    bf16_t* B3 = (bf16_t*)(a.ws + WS_B3) + (size_t)g * 256 * 512;
    f32x2* AT = (f32x2*)(a.ws + WS_AT);
    if (tid < 128) {
        const int dir = tid >> 6, p = tid & 63; const int idx = (dir * 32 + g) * 64 + p;
        const float lr = lam_re[idx], li = lam_im[idx], dt = expf(log_dt[dir * 32 + g]);
        for (int k = 0; k <= 16; ++k) { const float mg = expf(lr * dt * (float)k), ang = li * dt * (float)k; apow[(dir * 17 + k) * 64 + p] = (f32x2){mg * cosf(ang), mg * sinf(ang)}; }
        const f32x2 a1 = apow[(dir * 17 + 1) * 64 + p]; const float den = lr * lr + li * li;
        zt[dir * 64 + p] = (f32x2){((a1.x - 1.0f) * lr + a1.y * li) / den, (a1.y * lr - (a1.x - 1.0f) * li) / den};
        AT[idx] = apow[(dir * 17 + 16) * 64 + p];
    }
    __syncthreads();
    for (int e = tid; e < 2048; e += 512) { const int dir = e >> 10, p = (e >> 4) & 63, h = e & 15; const size_t gi = ((size_t)(dir * 32 + g) * 64 + p) * 16 + h;
        const float br = b_re[gi], bi = b_im[gi]; const f32x2 z = zt[dir * 64 + p]; bbar[e] = (f32x2){z.x * br - z.y * bi, z.x * bi + z.y * br}; }
    __syncthreads();
    for (int e = tid; e < 31 * 256; e += 512) { const int lag = e / 256 - 15, hp = (e >> 4) & 15, h = e & 15; float sum = 0.f;
        if (lag >= 0) { const size_t ci = ((size_t)(0 * 32 + g) * 16 + hp) * 64;
            for (int p = 0; p < 64; ++p) { const float cr = c_re[ci + p], cim = c_im[ci + p]; const f32x2 aw = apow[(0 * 17 + lag) * 64 + p]; const f32x2 b = bbar[(0 * 64 + p) * 16 + h];
                const float wr_ = cr * aw.x - cim * aw.y, wi_ = cr * aw.y + cim * aw.x; sum += wr_ * b.x - wi_ * b.y; } }
        if (lag <= 0) { const size_t ci = ((size_t)(1 * 32 + g) * 16 + hp) * 64;
            for (int p = 0; p < 64; ++p) { const float cr = c_re[ci + p], cim = c_im[ci + p]; const f32x2 aw = apow[(1 * 17 - lag) * 64 + p]; const f32x2 b = bbar[(1 * 64 + p) * 16 + h];
                const float wr_ = cr * aw.x - cim * aw.y, wi_ = cr * aw.y + cim * aw.x; sum += wr_ * b.x - wi_ * b.y; } }
        if (lag == 0 && hp == h) sum += d_skip[g * 16 + h];
        kmat[e] = sum; }
    __syncthreads();
    for (int e = tid; e < 256 * 256; e += 512) { const int n = e >> 8, k = (e & 255) * 2; const int i = n >> 4, hp = n & 15; float v0, v1;
        if (k < 256) { const int j = k >> 4, h = k & 15; const float* kp = kmat + (i - j + 15) * 256 + hp * 16 + h; v0 = kp[0]; v1 = kp[1]; }
        else { const int kk = k - 256, dir = kk >> 7, p = (kk >> 1) & 63; const int ee = dir == 0 ? i + 1 : 16 - i; const size_t ci = ((size_t)(dir * 32 + g) * 16 + hp) * 64 + p;
            const float cr = c_re[ci], cim = c_im[ci]; const f32x2 aw = apow[(dir * 17 + ee) * 64 + p]; v0 = cr * aw.x - cim * aw.y; v1 = -(cr * aw.y + cim * aw.x); }
        *(unsigned*)(B3 + (size_t)n * 512 + k) = cvt_pk_bf16(v0, v1); }
    for (int e = tid; e < 256 * 128; e += 512) { const int n = e >> 7, k = (e & 127) * 2; const int dir = n >> 7, p = (n >> 1) & 63, ri = n & 1, j = k >> 4, h = k & 15;
        const int ee = dir == 0 ? 15 - j : j; const f32x2 aw = apow[(dir * 17 + ee) * 64 + p]; const f32x2 b0 = bbar[(dir * 64 + p) * 16 + h], b1 = bbar[(dir * 64 + p) * 16 + h + 1];
        const float v0 = ri ? (aw.x * b0.y + aw.y * b0.x) : (aw.x * b0.x - aw.y * b0.y), v1 = ri ? (aw.x * b1.y + aw.y * b1.x) : (aw.x * b1.x - aw.y * b1.y);
        *(unsigned*)(B1 + (size_t)n * 512 + k) = cvt_pk_bf16(v0, v1); }
    __syncthreads();
}

__device__ __forceinline__ void sg_phase(const Args& a, unsigned char* lds) {
    const int tid = fresh_tid();
    bf16_t* VT = (bf16_t*)lds;
    const bf16_t* VB = (const bf16_t*)(a.ws + WS_VB); const bf16_t* UB = (const bf16_t*)(a.ws + WS_UB); bf16_t* YAB = (bf16_t*)(a.ws + WS_R1);
    const int lane = tid & 63, w = tid >> 6, fr = lane & 15, fq = lane >> 4;
    const int G = gridDim.x; int u = blockIdx.x;
    const int ch = tid & 15, j0 = tid >> 4;
    u32x4 vreg[4];
    if (u < 2560) {
#pragma unroll
        for (int it = 0; it < 4; ++it) vreg[it] = *(const u32x4*)(VB + ((size_t)(u >> 2) * 128 + j0 + 32 * it) * 512 + (u & 3) * 128 + ch * 8); }
    for (; u < 2560; u += G) { const int n = u >> 2, h = u & 3;
        const float* gmn = a.in[15] + h * 128; const float* Ws = a.in[16] + (size_t)h * 128 * 128; const float* bs = a.in[17] + h * 128;
        const int i = 16 * w + fr; const size_t tok = (size_t)n * 128 + i;
        u32x4 ub[4];
#pragma unroll
        for (int q = 0; q < 4; ++q) ub[q] = *(const u32x4*)(UB + tok * 512 + h * 128 + 32 * fq + 8 * q);
        f32x4 wv[4][2];
#pragma unroll
        for (int ks = 0; ks < 4; ++ks) { wv[ks][0] = *(const f32x4*)(Ws + (size_t)i * 128 + ks * 32 + fq * 8); wv[ks][1] = *(const f32x4*)(Ws + (size_t)i * 128 + ks * 32 + fq * 8 + 4); }
        const float bsv = bs[i];
        const f32x4 g0 = *(const f32x4*)(gmn + ch * 8), g1 = *(const f32x4*)(gmn + ch * 8 + 4);
        const float gg[8] = {g0.x, g0.y, g0.z, g0.w, g1.x, g1.y, g1.z, g1.w};
#pragma unroll
        for (int it = 0; it < 4; ++it) { const int j = j0 + 32 * it; const u32x4 v = vreg[it];
            float f[8] = {bf_lo(v.x), bf_hi(v.x), bf_lo(v.y), bf_hi(v.y), bf_lo(v.z), bf_hi(v.z), bf_lo(v.w), bf_hi(v.w)};
            float ss = 0.f;
#pragma unroll
            for (int e = 0; e < 8; ++e) ss += f[e] * f[e];
            ss += __shfl_xor(ss, 1); ss += __shfl_xor(ss, 2); ss += __shfl_xor(ss, 4); ss += __shfl_xor(ss, 8);
            const float rstd = rsqrtf(ss * (1.f / 128.f) + EPS);
#pragma unroll
            for (int e = 0; e < 8; e += 2) { const unsigned pk = cvt_pk_bf16(f[e] * rstd * gg[e], f[e + 1] * rstd * gg[e + 1]);
                const int d = ch * 8 + e, r0 = 16 * ((d >> 2) & 7) + 4 * (d >> 5) + (d & 3);
                VT[r0 * 136 + j] = (bf16_t)(pk & 0xffffu); VT[(r0 + 1) * 136 + j] = (bf16_t)(pk >> 16); } }
        __syncthreads();
        if (u + G < 2560) { const int u2 = u + G;
#pragma unroll
            for (int it = 0; it < 4; ++it) vreg[it] = *(const u32x4*)(VB + ((size_t)(u2 >> 2) * 128 + j0 + 32 * it) * 512 + (u2 & 3) * 128 + ch * 8); }
        bf16x8 bw[4];
#pragma unroll
        for (int ks = 0; ks < 4; ++ks) { const f32x4 w0 = wv[ks][0], w1 = wv[ks][1];
            u32x4 pk; pk.x = cvt_pk_bf16(w0.x, w0.y); pk.y = cvt_pk_bf16(w0.z, w0.w); pk.z = cvt_pk_bf16(w1.x, w1.y); pk.w = cvt_pk_bf16(w1.z, w1.w); bw[ks] = __builtin_bit_cast(bf16x8, pk); }
        f32x4 acc[8];
#pragma unroll
        for (int mt = 0; mt < 8; ++mt) { acc[mt] = (f32x4){0.f, 0.f, 0.f, 0.f};
#pragma unroll
            for (int ks = 0; ks < 4; ++ks) { const bf16x8 av = *(const bf16x8*)(VT + (mt * 16 + fr) * 136 + ks * 32 + fq * 8); acc[mt] = __builtin_amdgcn_mfma_f32_16x16x32_bf16(av, bw[ks], acc[mt], 0, 0, 0); } }
#pragma unroll
        for (int q = 0; q < 4; ++q) { const f32x4 a0 = acc[2 * q] + bsv, a1 = acc[2 * q + 1] + bsv; const u32x4 uv = ub[q]; u32x4 o;
            o.x = cvt_pk_bf16(bf_lo(uv.x) * a0[0], bf_hi(uv.x) * a0[1]); o.y = cvt_pk_bf16(bf_lo(uv.y) * a0[2], bf_hi(uv.y) * a0[3]);
            o.z = cvt_pk_bf16(bf_lo(uv.z) * a1[0], bf_hi(uv.z) * a1[1]); o.w = cvt_pk_bf16(bf_lo(uv.w) * a1[2], bf_hi(uv.w) * a1[3]);
            *(u32x4*)(YAB + tok * 1024 + 512 + h * 128 + 32 * fq + 8 * q) = o; }
        __syncthreads();
    }
}

__device__ __forceinline__ void scan_unit(const Args& a, int unit, int t) {
    const int s = unit >> 5, g = unit & 31; const int nc = s < 4 ? 256 : 512; const int bc0 = s < 4 ? s * 256 : 1024 + (s - 4) * 512;
    const int dir = t >> 6, p = t & 63;
    const f32x2 aT = ((const f32x2*)(a.ws + WS_AT))[(dir * 32 + g) * 64 + p];
    const bf16_t* E = (const bf16_t*)(a.ws + WS_E) + ((size_t)(g * NCH + bc0) * 256 + 2 * t);
    bf16_t* A2 = (bf16_t*)(a.ws + WS_A2) + ((size_t)(g * NCH + bc0) * 512 + 256 + 2 * t);
    float sr = 0.f, si = 0.f;
    for (int c0 = 0; c0 < nc; c0 += 32) {
        unsigned ev[32];
#pragma unroll
        for (int q = 0; q < 32; ++q) { const int c = dir == 0 ? c0 + q : nc - 1 - c0 - q; ev[q] = *(const unsigned*)(E + (size_t)c * 256); }
#pragma unroll
        for (int q = 0; q < 32; ++q) { const int c = dir == 0 ? c0 + q : nc - 1 - c0 - q;
            *(unsigned*)(A2 + (size_t)c * 512) = cvt_pk_bf16(sr, si);
            const float nr = aT.x * sr - aT.y * si + bf_lo(ev[q]), ni = aT.x * si + aT.y * sr + bf_hi(ev[q]); sr = nr; si = ni; }
    }
}

constexpr int KP = 72, VP = 408;
__device__ __forceinline__ void attn_unit(const Args& a, int s, int qb, int kvh, bool cont, unsigned char* lds) {
    const int tid = fresh_tid();
    bf16_t* Kl = (bf16_t*)lds;
    bf16_t* VT = Kl + 400 * KP;
    float* biasL = (float*)(VT + 64 * VP);
    const bf16_t* QKV = (const bf16_t*)(a.ws + WS_R2); bf16_t* O = (bf16_t*)(a.ws + WS_R1);
    const float* qn = a.in[20]; const float* kn = a.in[21]; const float* sinkp = a.in[22]; const float* BIAS = (const float*)(a.ws + WS_BIAS);
    const int L = s < 4 ? 4096 : 8192; const size_t rowbase = s < 4 ? (size_t)s * 4096 : (size_t)MP + (size_t)(s - 4) * 8192;
    const int q0 = qb * 128; const int lane = tid & 63, w = tid >> 6, fr = lane & 15, fq = lane >> 4;
    const bf16_t* qbase = QKV + (rowbase + q0 + (w & 1) * 64 + fr) * 1536 + (kvh * 4 + (w >> 1)) * 64 + fq * 8;
    u32x4 qn0 = *(const u32x4*)qbase, qn1 = *(const u32x4*)(qbase + 32), qn2 = *(const u32x4*)(qbase + 16 * 1536), qn3 = *(const u32x4*)(qbase + 16 * 1536 + 32);
    const int k_lo = cont ? 256 : 0, npieces = (384 - k_lo) * 8;
    u32x4 kvr[6], vvr[6];
#pragma unroll
    for (int it = 0; it < 6; ++it) { const int piece = tid + 512 * it; const int kk = k_lo + (piece >> 3), ch = piece & 7; const int kpos = q0 - 128 + kk; const bool valid = piece < npieces && kpos >= 0 && kpos < L;
        kvr[it] = (u32x4){0u, 0u, 0u, 0u}; vvr[it] = (u32x4){0u, 0u, 0u, 0u};
        if (valid) { const bf16_t* rp = QKV + (rowbase + kpos) * 1536 + kvh * 64 + ch * 8; kvr[it] = *(const u32x4*)(rp + 1024); vvr[it] = *(const u32x4*)(rp + 1280); } }
    const f32x4 g0 = *(const f32x4*)(kn + (tid & 7) * 8), g1 = *(const f32x4*)(kn + (tid & 7) * 8 + 4);
#pragma unroll
    for (int it = 0; it < 6; ++it) { const int piece = tid + 512 * it; const int kk = k_lo + (piece >> 3), ch = piece & 7;
        if (piece < npieces) { const int slot = (q0 + 256 + kk) % 384;
        const u32x4 kv = kvr[it], vv = vvr[it];
        float f[8] = {bf_lo(kv.x), bf_hi(kv.x), bf_lo(kv.y), bf_hi(kv.y), bf_lo(kv.z), bf_hi(kv.z), bf_lo(kv.w), bf_hi(kv.w)};
        float ss = 0.f;
#pragma unroll
        for (int e = 0; e < 8; ++e) ss += f[e] * f[e];
        ss += __shfl_xor(ss, 1); ss += __shfl_xor(ss, 2); ss += __shfl_xor(ss, 4);
        const float rstd = rsqrtf(ss * (1.f / 64.f) + EPS);
        u32x4 o; o.x = cvt_pk_bf16(f[0] * rstd * g0.x, f[1] * rstd * g0.y); o.y = cvt_pk_bf16(f[2] * rstd * g0.z, f[3] * rstd * g0.w);
        o.z = cvt_pk_bf16(f[4] * rstd * g1.x, f[5] * rstd * g1.y); o.w = cvt_pk_bf16(f[6] * rstd * g1.z, f[7] * rstd * g1.w);
        *(u32x4*)(Kl + slot * KP + ch * 8) = o;
        const unsigned vw[4] = {vv.x, vv.y, vv.z, vv.w};
#pragma unroll
        for (int e = 0; e < 4; ++e) { const int d0 = ch * 8 + 2 * e, r0 = ((d0 >> 2) & 3) * 16 + (d0 >> 4) * 4 + (d0 & 3);
            VT[r0 * VP + slot] = (bf16_t)(vw[e] & 0xffffu); VT[(r0 + 1) * VP + slot] = (bf16_t)(vw[e] >> 16); } } }
    if (!cont)
    for (int idx = tid; idx < 4 * 304; idx += 512) { const int hq = idx / 304, ii = idx % 304 - 16; biasL[idx] = (ii >= 0 && ii <= 256) ? BIAS[(kvh * 4 + hq) * 257 + ii] : 0.f; }
    __syncthreads();
    const int hq = w >> 1, H = kvh * 4 + hq; const float sink = sinkp[H] * 1.4426950408889634f; const bool edge = (q0 == 0) || (q0 + 128 == L);
    const float* bl = biasL + hq * 304 + 16;
#define MAKE_QF(R0, R1, QF) { const u32x4 r0 = R0, r1 = R1; \
          float f[16] = {bf_lo(r0.x), bf_hi(r0.x), bf_lo(r0.y), bf_hi(r0.y), bf_lo(r0.z), bf_hi(r0.z), bf_lo(r0.w), bf_hi(r0.w), bf_lo(r1.x), bf_hi(r1.x), bf_lo(r1.y), bf_hi(r1.y), bf_lo(r1.z), bf_hi(r1.z), bf_lo(r1.w), bf_hi(r1.w)}; \
          float ss = 0.f; \
          _Pragma("unroll") for (int e = 0; e < 16; ++e) ss += f[e] * f[e]; \
          ss += __shfl_xor(ss, 16); ss += __shfl_xor(ss, 32); \
          const float rstd = rsqrtf(ss * (1.f / 64.f) + EPS) * (0.125f * 1.4426950408889634f); \
          u32x4 p0, p1; \
          p0.x = cvt_pk_bf16(f[0] * rstd * qg[0].x, f[1] * rstd * qg[0].y); p0.y = cvt_pk_bf16(f[2] * rstd * qg[0].z, f[3] * rstd * qg[0].w); \
          p0.z = cvt_pk_bf16(f[4] * rstd * qg[1].x, f[5] * rstd * qg[1].y); p0.w = cvt_pk_bf16(f[6] * rstd * qg[1].z, f[7] * rstd * qg[1].w); \
          p1.x = cvt_pk_bf16(f[8] * rstd * qg[2].x, f[9] * rstd * qg[2].y); p1.y = cvt_pk_bf16(f[10] * rstd * qg[2].z, f[11] * rstd * qg[2].w); \
          p1.z = cvt_pk_bf16(f[12] * rstd * qg[3].x, f[13] * rstd * qg[3].y); p1.w = cvt_pk_bf16(f[14] * rstd * qg[3].z, f[15] * rstd * qg[3].w); \
          QF[0] = __builtin_bit_cast(bf16x8, p0); QF[1] = __builtin_bit_cast(bf16x8, p1); }
#pragma unroll 1
    for (int pr = 0; pr < 2; ++pr) { const int qs = (w & 1) * 64 + pr * 32;
        bf16x8 qfA[2], qfB[2];
        { f32x4 qg[4];
#pragma unroll
          for (int e = 0; e < 2; ++e) { qg[2 * e] = *(const f32x4*)(qn + e * 32 + fq * 8); qg[2 * e + 1] = *(const f32x4*)(qn + e * 32 + fq * 8 + 4); }
          MAKE_QF(qn0, qn1, qfA) MAKE_QF(qn2, qn3, qfB) }
        f32x4 SA[18], SB[18];
        const int base0 = (q0 + 256 + qs) % 384;
        const LAS unsigned char* kb3 = (const LAS unsigned char*)(Kl + fr * KP + fq * 8); const LAS unsigned char* bb3 = (const LAS unsigned char*)(bl + 4 * fq - fr);
        const LAS unsigned char* vb3 = (const LAS unsigned char*)(VT + fr * VP + 4 * fq);
        {   bf16x8 kf[2][2]; f32x4 bi[2]; f32x4 bprev = {0.f, 0.f, 0.f, 0.f};
#define LDK(buf, kt) { const int sl_ = base0 + 16 * (kt) - ((base0 + 16 * (kt) >= 384) ? 384 : 0); const LAS unsigned char* kp_ = kb3 + sl_ * (KP * 2); \
                _Pragma("unroll") for (int ks = 0; ks < 2; ++ks) kf[buf][ks] = *(const LAS bf16x8*)(kp_ + ks * 64); \
                if ((kt) < 17) { _Pragma("unroll") for (int r = 0; r < 4; ++r) bi[buf][r] = *(const LAS float*)(bb3 + ((kt) * 16 + r) * 4); } }
            LDK(0, 0)
#pragma unroll
            for (int kt = 0; kt < 18; ++kt) {
                if (kt < 17) { LDK((kt + 1) & 1, kt + 1) }
                __builtin_amdgcn_sched_barrier(0);
                if (kt < 17) { f32x4 acc = bi[kt & 1];
                    acc = __builtin_amdgcn_mfma_f32_16x16x32_bf16(kf[kt & 1][0], qfA[0], acc, 0, 0, 0); acc = __builtin_amdgcn_mfma_f32_16x16x32_bf16(kf[kt & 1][1], qfA[1], acc, 0, 0, 0); SA[kt] = acc; }
                if (kt >= 1) { f32x4 acc = bprev;
                    acc = __builtin_amdgcn_mfma_f32_16x16x32_bf16(kf[kt & 1][0], qfB[0], acc, 0, 0, 0); acc = __builtin_amdgcn_mfma_f32_16x16x32_bf16(kf[kt & 1][1], qfB[1], acc, 0, 0, 0); SB[kt] = acc; }
                if (kt < 17) bprev = bi[kt & 1];
                __builtin_amdgcn_sched_barrier(0);
            }
#undef LDK
        }
        u32x2 vf[1][4][2];
#define LDV(buf, kp) { const int cl_ = base0 + 32 * (kp) - ((base0 + 32 * (kp) >= 384) ? 384 : 0); const LAS unsigned char* vp_ = vb3 + cl_ * 2; \
        _Pragma("unroll") for (int dt = 0; dt < 4; ++dt) { vf[buf][dt][0] = *(const LAS u32x2*)(vp_ + (dt * 16 * VP) * 2); vf[buf][dt][1] = *(const LAS u32x2*)(vp_ + (dt * 16 * VP + 16) * 2); } }
#pragma unroll
        for (int r = 0; r < 4; ++r) { if (4 * fq + r - fr < 0) { SA[0][r] = -1e30f; SB[1][r] = -1e30f; } if (4 * fq + r - fr > 0) { SA[16][r] = -1e30f; SB[17][r] = -1e30f; } }
        if (edge) {
#pragma unroll
            for (int kt = 0; kt < 18; ++kt)
#pragma unroll
                for (int r = 0; r < 4; ++r) { const int kpos = q0 - 128 + qs + kt * 16 + 4 * fq + r; if (kpos < 0 || kpos >= L) { if (kt < 17) SA[kt][r] = -1e30f; if (kt >= 1) SB[kt][r] = -1e30f; } } }
        float invA, invB;
        {   float mx = sink;
#pragma unroll
            for (int kt = 0; kt < 17; ++kt)
#pragma unroll
                for (int r = 0; r < 4; ++r) mx = fmaxf(mx, SA[kt][r]);
            mx = fmaxf(mx, __shfl_xor(mx, 16)); mx = fmaxf(mx, __shfl_xor(mx, 32));
            f32x4 sumv = {0.f, 0.f, 0.f, 0.f}; const f32x4 mxv = {mx, mx, mx, mx};
#pragma unroll
            for (int kt = 0; kt < 17; ++kt) { f32x4 d = SA[kt] - mxv;
#pragma unroll
                for (int r = 0; r < 4; ++r) d[r] = __builtin_amdgcn_exp2f(d[r]);
                SA[kt] = d; sumv += d; }
            float sum = (sumv[0] + sumv[1]) + (sumv[2] + sumv[3]);
            sum += __shfl_xor(sum, 16); sum += __shfl_xor(sum, 32); sum += __builtin_amdgcn_exp2f(sink - mx);
            invA = 1.0f / sum; SA[17] = (f32x4){0.f, 0.f, 0.f, 0.f}; }
        {   float mx = sink;
#pragma unroll
            for (int kt = 1; kt < 18; ++kt)
#pragma unroll
                for (int r = 0; r < 4; ++r) mx = fmaxf(mx, SB[kt][r]);
            mx = fmaxf(mx, __shfl_xor(mx, 16)); mx = fmaxf(mx, __shfl_xor(mx, 32));
            f32x4 sumv = {0.f, 0.f, 0.f, 0.f}; const f32x4 mxv = {mx, mx, mx, mx};
#pragma unroll
            for (int kt = 1; kt < 18; ++kt) { f32x4 d = SB[kt] - mxv;
#pragma unroll
                for (int r = 0; r < 4; ++r) d[r] = __builtin_amdgcn_exp2f(d[r]);
                SB[kt] = d; sumv += d; }
            float sum = (sumv[0] + sumv[1]) + (sumv[2] + sumv[3]);
            sum += __shfl_xor(sum, 16); sum += __shfl_xor(sum, 32); sum += __builtin_amdgcn_exp2f(sink - mx);
            invB = 1.0f / sum; SB[0] = (f32x4){0.f, 0.f, 0.f, 0.f}; }
        f32x4 OcA[4], OcB[4];
#pragma unroll
        for (int dt = 0; dt < 4; ++dt) { OcA[dt] = (f32x4){0.f, 0.f, 0.f, 0.f}; OcB[dt] = (f32x4){0.f, 0.f, 0.f, 0.f}; }
#pragma unroll
        for (int kp = 0; kp < 9; ++kp) {
            LDV(0, kp)
            u32x4 pa, pb_;
            pa.x = cvt_pk_bf16(SA[2 * kp][0], SA[2 * kp][1]); pa.y = cvt_pk_bf16(SA[2 * kp][2], SA[2 * kp][3]); pa.z = cvt_pk_bf16(SA[2 * kp + 1][0], SA[2 * kp + 1][1]); pa.w = cvt_pk_bf16(SA[2 * kp + 1][2], SA[2 * kp + 1][3]);
            pb_.x = cvt_pk_bf16(SB[2 * kp][0], SB[2 * kp][1]); pb_.y = cvt_pk_bf16(SB[2 * kp][2], SB[2 * kp][3]); pb_.z = cvt_pk_bf16(SB[2 * kp + 1][0], SB[2 * kp + 1][1]); pb_.w = cvt_pk_bf16(SB[2 * kp + 1][2], SB[2 * kp + 1][3]);
            const bf16x8 pA = __builtin_bit_cast(bf16x8, pa), pB = __builtin_bit_cast(bf16x8, pb_);
#pragma unroll
            for (int dt = 0; dt < 4; ++dt) { u32x4 av; av.x = vf[0][dt][0].x; av.y = vf[0][dt][0].y; av.z = vf[0][dt][1].x; av.w = vf[0][dt][1].y;
                const bf16x8 avf = __builtin_bit_cast(bf16x8, av);
                OcA[dt] = __builtin_amdgcn_mfma_f32_16x16x32_bf16(avf, pA, OcA[dt], 0, 0, 0); OcB[dt] = __builtin_amdgcn_mfma_f32_16x16x32_bf16(avf, pB, OcB[dt], 0, 0, 0); }
            __builtin_amdgcn_sched_barrier(0);
        }
#undef LDV
        { u32x4 o0, o1;
          o0.x = cvt_pk_bf16(OcA[0][0] * invA, OcA[0][1] * invA); o0.y = cvt_pk_bf16(OcA[0][2] * invA, OcA[0][3] * invA); o0.z = cvt_pk_bf16(OcA[1][0] * invA, OcA[1][1] * invA); o0.w = cvt_pk_bf16(OcA[1][2] * invA, OcA[1][3] * invA);
          o1.x = cvt_pk_bf16(OcA[2][0] * invA, OcA[2][1] * invA); o1.y = cvt_pk_bf16(OcA[2][2] * invA, OcA[2][3] * invA); o1.z = cvt_pk_bf16(OcA[3][0] * invA, OcA[3][1] * invA); o1.w = cvt_pk_bf16(OcA[3][2] * invA, OcA[3][3] * invA);
          bf16_t* op = O + (unsigned)(((unsigned)rowbase + q0 + qs + fr) * 1024u + H * 64 + 16 * fq); *(u32x4*)op = o0; *(u32x4*)(op + 8) = o1;
          o0.x = cvt_pk_bf16(OcB[0][0] * invB, OcB[0][1] * invB); o0.y = cvt_pk_bf16(OcB[0][2] * invB, OcB[0][3] * invB); o0.z = cvt_pk_bf16(OcB[1][0] * invB, OcB[1][1] * invB); o0.w = cvt_pk_bf16(OcB[1][2] * invB, OcB[1][3] * invB);
          o1.x = cvt_pk_bf16(OcB[2][0] * invB, OcB[2][1] * invB); o1.y = cvt_pk_bf16(OcB[2][2] * invB, OcB[2][3] * invB); o1.z = cvt_pk_bf16(OcB[3][0] * invB, OcB[3][1] * invB); o1.w = cvt_pk_bf16(OcB[3][2] * invB, OcB[3][3] * invB);
          op += 16 * 1024; *(u32x4*)op = o0; *(u32x4*)(op + 8) = o1; }
        if (pr == 0) { const bf16_t* qb2 = QKV + (unsigned)(((unsigned)rowbase + q0 + (w & 1) * 64 + 32 + fr) * 1536u + (kvh * 4 + (w >> 1)) * 64 + fq * 8);
            qn0 = *(const u32x4*)qb2; qn1 = *(const u32x4*)(qb2 + 32); qn2 = *(const u32x4*)(qb2 + 16 * 1536); qn3 = *(const u32x4*)(qb2 + 16 * 1536 + 32); }
    }
#undef MAKE_QF
    __syncthreads();
}

__device__ __forceinline__ int rel_bucket(int rel) {
    const int n = rel < 0 ? -rel : rel; int ret = rel > 0 ? 16 : 0;
    int large = 8; if (n >= 8) { const unsigned q = (unsigned)(n * n) >> 6; large = 8 + (31 - __builtin_clz(q)); } if (large > 15) large = 15;
    return ret + (n < 8 ? n : large);
}

#define XB_TMO      128
#define XB_XCNT(j)  (256  + 64 * (j))
#define XB_XSUB(j)  (1280 + 64 * (j))
#define XB_XGEN(j)  (2304 + 64 * (j))
#define XB_TOP      3328
#define XB_TOPGEN   3392
#define XCD_BAR_WORDS 3456
#define XB_SPIN_CAP (1u << 22)

__device__ __forceinline__ unsigned xb_ld(unsigned* p)              { return __hip_atomic_load(p, __ATOMIC_RELAXED, __HIP_MEMORY_SCOPE_AGENT); }
__device__ __forceinline__ unsigned xb_add(unsigned* p, unsigned v) { return __hip_atomic_fetch_add(p, v, __ATOMIC_RELAXED, __HIP_MEMORY_SCOPE_AGENT); }
__device__ __forceinline__ unsigned xb_xcc_id() { return (unsigned)__builtin_amdgcn_s_getreg((3 << 11) | 20) & 0xFu; }
#define XB_SPIN(cond, bar) do { unsigned _sp = 0; while (cond) { __builtin_amdgcn_s_sleep(1); \
    if ((++_sp & 255u) == 0u) { if (xb_ld(&(bar)[XB_TMO])) break; if (_sp > XB_SPIN_CAP) { atomicAdd(&(bar)[XB_TMO], 1u); break; } } } } while (0)

struct XcdBarrier {
    unsigned* bar; unsigned x;
    volatile LAS unsigned* st;
};

__device__ __forceinline__ XcdBarrier xcd_barrier_post(unsigned* bar, volatile LAS unsigned* st) {
    XcdBarrier b; b.bar = bar; b.x = xb_xcc_id(); b.st = st;
    if (threadIdx.x == 0) (void)xb_add(&bar[XB_XCNT(b.x)], 1u);
    return b;
}
__device__ __forceinline__ void xcd_barrier_complete(unsigned* bar, unsigned x, unsigned& nloc, unsigned& nx) {
    const unsigned G = gridDim.x * gridDim.y * gridDim.z;
    unsigned sum, cnt, mine, sp = 0u;
    for (;;) {
        sum = 0u; cnt = 0u; mine = 0u;
#pragma unroll
        for (unsigned j = 0; j < 16; ++j) { const unsigned c = xb_ld(&bar[XB_XCNT(j)]); sum += c; cnt += (c > 0u) ? 1u : 0u; mine = (j == x) ? c : mine; }
        if (sum == G) break;
        __builtin_amdgcn_s_sleep(1);
        if ((++sp & 255u) == 0u) { if (xb_ld(&bar[XB_TMO])) break; if (sp > XB_SPIN_CAP) { atomicAdd(&bar[XB_TMO], 1u); break; } }
    }
    nloc = mine > 0u ? mine : 1u; nx = cnt > 0u ? cnt : 1u;
}

__device__ __forceinline__ void xcd_barrier(const XcdBarrier& b) {
    asm volatile("s_waitcnt vmcnt(0)" ::: "memory");
    __syncthreads();
    if (threadIdx.x == 0) {
        unsigned* bar = b.bar;
        __builtin_amdgcn_s_waitcnt(0);
        unsigned nloc = b.st[0], nx = b.st[1];
        if (nloc == 0u) { xcd_barrier_complete(bar, b.x, nloc, nx); b.st[0] = nloc; b.st[1] = nx; }
        const unsigned old = xb_add(&bar[XB_XSUB(b.x)], 1u);
        const unsigned gen = old / nloc;
        if (old + 1u == (gen + 1u) * nloc) {
            __builtin_amdgcn_fence(__ATOMIC_RELEASE, "agent");
            asm volatile("s_waitcnt vmcnt(0)" ::: "memory");
            const unsigned og = xb_add(&bar[XB_TOP], 1u);
            const unsigned tg = og / nx;
            if (og + 1u == (tg + 1u) * nx) xb_add(&bar[XB_TOPGEN], 1u);
            else XB_SPIN(xb_ld(&bar[XB_TOPGEN]) == tg, bar);
            __builtin_amdgcn_fence(__ATOMIC_ACQUIRE, "agent");
            xb_add(&bar[XB_XGEN(b.x)], 1u);
            asm volatile("s_waitcnt vmcnt(0)" ::: "memory");
        } else {
            XB_SPIN(xb_ld(&bar[XB_XGEN(b.x)]) == gen, bar);
            __builtin_amdgcn_fence(__ATOMIC_ACQUIRE, "agent");
            asm volatile("s_waitcnt vmcnt(0)" ::: "memory");
        }
    }
    __syncthreads();
}

__global__ void __launch_bounds__(512, 2) fwd_kernel(Args a) {
    extern __shared__ __attribute__((aligned(16))) unsigned char lds[];
    cg::grid_group grid = cg::this_grid();
    LAS unsigned char* lds3 = (LAS unsigned char*)lds;
    const int G = gridDim.x, bx = blockIdx.x;
    unsigned char* ws = a.ws;
    volatile LAS unsigned* bst = (volatile LAS unsigned*)(lds3 + 131072 + 64);
    { const int t0 = fresh_tid(); if (t0 < 2) bst[t0] = 0u;
      if (bx == 0) for (int e = t0; e < XCD_BAR_WORDS; e += 512) ((unsigned*)(ws + WS_BAR))[e] = 0u; }
    __syncthreads();

    #ifndef NO_S5P
    if (bx < 32) s5_prep(a, bx, lds);
#endif
    {
        const int tid = fresh_tid(), lane = tid & 63, wave = tid >> 6, gw = bx * 8 + wave, NGW = G * 8;
        float* scr = (float*)(lds + wave * 16384);
        constexpr int I_IN = 16 * 48, I_GLU = 8 * 16, I_OUT = 16 * 32, I_QKV = 16 * 48, I_O = 16 * 32, I_G = 16 * 88, I_D = 44 * 32;
        constexpr int NITEMS = I_IN + I_GLU + I_OUT + I_QKV + I_O + 4 * I_G + 2 * I_D;
        for (int it = gw; it < NITEMS; it += NGW) {
            int r = it;
            if (r < I_IN) { transpose_item(a.in[4], 1024, 1536, (bf16_t*)(ws + WS_WIN), 0, scr, r, lane, a.in[2]); continue; } r -= I_IN;
            if (r < I_GLU) { transpose_item(a.in[13], 512, 512, (bf16_t*)(ws + WS_WGLU), 0, scr, r, lane); continue; } r -= I_GLU;
            if (r < I_OUT) { transpose_item(a.in[18], 1024, 1024, (bf16_t*)(ws + WS_WOUT), 0, scr, r, lane); continue; } r -= I_OUT;
            if (r < I_QKV) { transpose_item(a.in[19], 1024, 1536, (bf16_t*)(ws + WS_WQKV), 0, scr, r, lane, a.in[2] + DM); continue; } r -= I_QKV;
            if (r < I_O) { transpose_item(a.in[23], 1024, 1024, (bf16_t*)(ws + WS_WO), 0, scr, r, lane); continue; } r -= I_O;
            if (r < 4 * I_G) { const int l = r / (2 * I_G), rr = r % (2 * I_G), up = rr / I_G, item = rr % I_G;
                transpose_item(a.in[up ? 26 : 25] + (size_t)l * 1024 * DFF, 1024, DFF, (bf16_t*)(ws + (l ? WS_WGU1 : WS_WGU0)), up ? 2 : 1, scr, item, lane, a.in[3] + l * DM); continue; } r -= 4 * I_G;
            { const int l = r / I_D, item = r % I_D; transpose_item(a.in[27] + (size_t)l * DFF * 1024, DFF, 1024, (bf16_t*)(ws + (l ? WS_WD1 : WS_WD0)), 0, scr, item, lane); }
        }
        for (int e = bx * 512 + tid; e < 16 * 257; e += G * 512) { const int h = e / 257, rel = e % 257 - 128; ((float*)(ws + WS_BIAS))[e] = a.in[24][rel_bucket(rel) * 16 + h] * 1.4426950408889634f; }
        for (int e = bx * 512 + tid; e < 3 * MT; e += G * 512) ((float*)(ws + WS_SSQ))[e] = 0.f;
        rms_rows(a.in[0], a.in[1], a.in[2], (bf16_t*)(ws + WS_XB), (float*)(ws + WS_SSQ) + 3 * MT);
    }
    grid.sync();
    const XcdBarrier xbar = xcd_barrier_post((unsigned*)(ws + WS_BAR), bst);

    { constexpr int layer = 0;
        if constexpr (layer == 0) {
            { pg8::Gemm g{(const bf16_t*)(ws + WS_XB), (const bf16_t*)(ws + WS_WIN), 1024, 1024, 1024, 0, 0, 0}; pg8::StaticOrder S; S.init(MT, 1536, G, bx);
              pg8::EpiIn E{(bf16_t*)(ws + WS_A2), (bf16_t*)(ws + WS_UB), (bf16_t*)(ws + WS_VB)};
              pg8::gemm_phase(lds3, g, S, E); }
            xcd_barrier(xbar);
            { pg8::Gemm g{(const bf16_t*)(ws + WS_A2), (const bf16_t*)(ws + WS_B1), 256, 512, 512, 0, 0, 0}; pg8::GroupedOrder S{G, bx};
              pg8::EpiE E{(bf16_t*)(ws + WS_E)};
              pg8::gemm_phase(lds3, g, S, E); }
            __syncthreads();
#ifndef NO_SG
            sg_phase(a, lds);
#endif
            xcd_barrier(xbar);
            { const int tid_ = fresh_tid(); const int sub = tid_ >> 7, t = tid_ & 127; const int unit = sub * G + bx;
#ifndef NO_SCAN
              if (unit < 384) scan_unit(a, unit, t);
#endif
            }
            xcd_barrier(xbar);
            { pg8::Gemm g{(const bf16_t*)(ws + WS_A2), (const bf16_t*)(ws + WS_B3), 512, 512, 512, 0, 0, 0}; pg8::GroupedOrder S{G, bx};
              pg8::EpiS3 E{(bf16_t*)(ws + WS_YG)};
              pg8::gemm_phase(lds3, g, S, E); }
            xcd_barrier(xbar);
            { pg8::Gemm g{(const bf16_t*)(ws + WS_YG), (const bf16_t*)(ws + WS_WGLU), 512, 16, 512, 4u * NCH * 256u * 2u, 256u * 16u * 2u, 1}; pg8::StaticOrder S; S.init(MT, 512, G, bx);
              pg8::EpiGlu E{(const bf16_t*)(ws + WS_YG), a.in[14], (bf16_t*)(ws + WS_R1)};
              pg8::gemm_phase(lds3, g, S, E); }
            xcd_barrier(xbar);
        } else {
            { pg8::Gemm g{(const bf16_t*)(ws + WS_XB), (const bf16_t*)(ws + WS_WQKV), 1024, 1024, 1024, 0, 0, 0}; pg8::StaticOrder S; S.init(MT, 1536, G, bx);
              pg8::EpiBf16 E{(bf16_t*)(ws + WS_R2), 1536, (const float*)(ws + WS_SSQ) + MT};
              pg8::gemm_phase(lds3, g, S, E); }
            xcd_barrier(xbar);
            { const int u_lo = (int)((long)bx * 2560 / G), u_hi = (int)((long)(bx + 1) * 2560 / G); int pst = -1, pqb = -2;
              for (int U = u_lo; U < u_hi; ++U) { int st, qb; if (U < 512) { st = U >> 5; qb = U & 31; } else { st = 16 + ((U - 512) >> 6); qb = (U - 512) & 63; }
                const int s = st >> 2, kvh = st & 3; const bool cont = (st == pst) && (qb == pqb + 1); pst = st; pqb = qb;
                attn_unit(a, s, qb, kvh, cont, lds); } }
            xcd_barrier(xbar);
        }
        { pg8::Gemm g{(const bf16_t*)(ws + WS_R1), (const bf16_t*)(ws + (layer ? WS_WO : WS_WOUT)), 1024, 1024, 1024, 0, 0, 0}; pg8::StaticOrder S; S.init(MT, 1024, G, bx);
          if constexpr (layer == 0) { pg8::EpiRes<3> E{a.in[2], (const float*)(ws + WS_SSQ) + 3 * MT, nullptr, (bf16_t*)(ws + WS_XB), (float*)(ws + WS_SSQ)}; pg8::gemm_phase(lds3, g, S, E); }
          else { pg8::EpiRes<1> E{nullptr, nullptr, nullptr, (bf16_t*)(ws + WS_XB), (float*)(ws + WS_SSQ) + 2 * MT}; pg8::gemm_phase(lds3, g, S, E); } }
        xcd_barrier(xbar);
        { pg8::Gemm g{(const bf16_t*)(ws + WS_XB), (const bf16_t*)(ws + (layer ? WS_WGU1 : WS_WGU0)), 1024, 1024, 1024, 0, 0, 0}; pg8::StaticOrder S; S.init(MT, NGU, G, bx);
          pg8::EpiSwiglu E{(bf16_t*)(ws + WS_R2), (const float*)(ws + WS_SSQ) + (layer ? 2 * MT : 0)};
          pg8::gemm_phase(lds3, g, S, E); }
        xcd_barrier(xbar);
        { pg8::Gemm g{(const bf16_t*)(ws + WS_R2), (const bf16_t*)(ws + (layer ? WS_WD1 : WS_WD0)), DFF, DFF, DFF, 0, 0, 0}; pg8::StaticOrder S; S.init(MT, 1024, G, bx, true);
          if constexpr (layer == 0) { pg8::EpiRes<1> E{nullptr, nullptr, nullptr, (bf16_t*)(ws + WS_XB), (float*)(ws + WS_SSQ) + MT}; pg8::gemm_phase(lds3, g, S, E); xcd_barrier(xbar); }
          else { pg8::EpiRes<2> E{nullptr, nullptr, a.out, (bf16_t*)(ws + WS_XB), nullptr}; pg8::gemm_phase(lds3, g, S, E); } }
    }
    { constexpr int layer = 1;
        if constexpr (layer == 0) {
            { pg8::Gemm g{(const bf16_t*)(ws + WS_XB), (const bf16_t*)(ws + WS_WIN), 1024, 1024, 1024, 0, 0, 0}; pg8::StaticOrder S; S.init(MT, 1536, G, bx);
              pg8::EpiIn E{(bf16_t*)(ws + WS_A2), (bf16_t*)(ws + WS_UB), (bf16_t*)(ws + WS_VB)};
              pg8::gemm_phase(lds3, g, S, E); }
            xcd_barrier(xbar);
            { pg8::Gemm g{(const bf16_t*)(ws + WS_A2), (const bf16_t*)(ws + WS_B1), 256, 512, 512, 0, 0, 0}; pg8::GroupedOrder S{G, bx};
              pg8::EpiE E{(bf16_t*)(ws + WS_E)};
              pg8::gemm_phase(lds3, g, S, E); }
            __syncthreads();
#ifndef NO_SG
            sg_phase(a, lds);
#endif
            xcd_barrier(xbar);
            { const int tid_ = fresh_tid(); const int sub = tid_ >> 7, t = tid_ & 127; const int unit = sub * G + bx;
#ifndef NO_SCAN
              if (unit < 384) scan_unit(a, unit, t);
#endif
            }
            xcd_barrier(xbar);
            { pg8::Gemm g{(const bf16_t*)(ws + WS_A2), (const bf16_t*)(ws + WS_B3), 512, 512, 512, 0, 0, 0}; pg8::GroupedOrder S{G, bx};
              pg8::EpiS3 E{(bf16_t*)(ws + WS_YG)};
              pg8::gemm_phase(lds3, g, S, E); }
            xcd_barrier(xbar);
            { pg8::Gemm g{(const bf16_t*)(ws + WS_YG), (const bf16_t*)(ws + WS_WGLU), 512, 16, 512, 4u * NCH * 256u * 2u, 256u * 16u * 2u, 1}; pg8::StaticOrder S; S.init(MT, 512, G, bx);
              pg8::EpiGlu E{(const bf16_t*)(ws + WS_YG), a.in[14], (bf16_t*)(ws + WS_R1)};
              pg8::gemm_phase(lds3, g, S, E); }
            xcd_barrier(xbar);
        } else {
            { pg8::Gemm g{(const bf16_t*)(ws + WS_XB), (const bf16_t*)(ws + WS_WQKV), 1024, 1024, 1024, 0, 0, 0}; pg8::StaticOrder S; S.init(MT, 1536, G, bx);
              pg8::EpiBf16 E{(bf16_t*)(ws + WS_R2), 1536, (const float*)(ws + WS_SSQ) + MT};
              pg8::gemm_phase(lds3, g, S, E); }
            xcd_barrier(xbar);
            { const int u_lo = (int)((long)bx * 2560 / G), u_hi = (int)((long)(bx + 1) * 2560 / G); int pst = -1, pqb = -2;
              for (int U = u_lo; U < u_hi; ++U) { int st, qb; if (U < 512) { st = U >> 5; qb = U & 31; } else { st = 16 + ((U - 512) >> 6); qb = (U - 512) & 63; }
                const int s = st >> 2, kvh = st & 3; const bool cont = (st == pst) && (qb == pqb + 1); pst = st; pqb = qb;
                attn_unit(a, s, qb, kvh, cont, lds); } }
            xcd_barrier(xbar);
        }
        { pg8::Gemm g{(const bf16_t*)(ws + WS_R1), (const bf16_t*)(ws + (layer ? WS_WO : WS_WOUT)), 1024, 1024, 1024, 0, 0, 0}; pg8::StaticOrder S; S.init(MT, 1024, G, bx);
          if constexpr (layer == 0) { pg8::EpiRes<3> E{a.in[2], (const float*)(ws + WS_SSQ) + 3 * MT, nullptr, (bf16_t*)(ws + WS_XB), (float*)(ws + WS_SSQ)}; pg8::gemm_phase(lds3, g, S, E); }
          else { pg8::EpiRes<1> E{nullptr, nullptr, nullptr, (bf16_t*)(ws + WS_XB), (float*)(ws + WS_SSQ) + 2 * MT}; pg8::gemm_phase(lds3, g, S, E); } }
        xcd_barrier(xbar);
        { pg8::Gemm g{(const bf16_t*)(ws + WS_XB), (const bf16_t*)(ws + (layer ? WS_WGU1 : WS_WGU0)), 1024, 1024, 1024, 0, 0, 0}; pg8::StaticOrder S; S.init(MT, NGU, G, bx);
          pg8::EpiSwiglu E{(bf16_t*)(ws + WS_R2), (const float*)(ws + WS_SSQ) + (layer ? 2 * MT : 0)};
          pg8::gemm_phase(lds3, g, S, E); }
        xcd_barrier(xbar);
        { pg8::Gemm g{(const bf16_t*)(ws + WS_R2), (const bf16_t*)(ws + (layer ? WS_WD1 : WS_WD0)), DFF, DFF, DFF, 0, 0, 0}; pg8::StaticOrder S; S.init(MT, 1024, G, bx, true);
          if constexpr (layer == 0) { pg8::EpiRes<1> E{nullptr, nullptr, nullptr, (bf16_t*)(ws + WS_XB), (float*)(ws + WS_SSQ) + MT}; pg8::gemm_phase(lds3, g, S, E); xcd_barrier(xbar); }
          else { pg8::EpiRes<2> E{nullptr, nullptr, a.out, (bf16_t*)(ws + WS_XB), nullptr}; pg8::gemm_phase(lds3, g, S, E); } }
    }
}

extern "C" void kernel_launch(void* const* d_in, const int* in_sizes, int n_in, void* d_out, int out_size, void* d_ws, size_t ws_size, hipStream_t stream) {
    static int grid = 0;
    if (grid == 0) {
        if (n_in != 28 || out_size != MT * DM || ws_size < WS_END) { fprintf(stderr, "kernel_launch: unexpected shapes (n_in %d out %d ws %zu)\n", n_in, out_size, ws_size); grid = -1; return; }
        int dev = 0, cus = 0, per_cu = 0;
        hipGetDevice(&dev); hipDeviceGetAttribute(&cus, hipDeviceAttributeMultiprocessorCount, dev);
        hipFuncSetAttribute((const void*)fwd_kernel, hipFuncAttributeMaxDynamicSharedMemorySize, LDS_BYTES);
        hipOccupancyMaxActiveBlocksPerMultiprocessor(&per_cu, (const void*)fwd_kernel, 512, LDS_BYTES);
        if (per_cu < 1) per_cu = 1;
        grid = cus * per_cu;
        (void)hipGetLastError();
    }
    if (grid < 0) return;
    Args a{};
    for (int i = 0; i < 28; ++i) a.in[i] = (const float*)d_in[i];
    a.out = (float*)d_out; a.ws = (unsigned char*)d_ws;
    void* args[] = {&a};
    hipError_t e = hipLaunchCooperativeKernel((const void*)fwd_kernel, dim3(grid), dim3(512), args, LDS_BYTES, stream);
    if (e != hipSuccess) fprintf(stderr, "cooperative launch failed: %s (grid %d)\n", hipGetErrorString(e), grid);
}
```

```cpp
#include <hip/hip_runtime.h>
#include <hip/hip_cooperative_groups.h>
#include <cstdio>
#include <cstdint>
namespace cg = cooperative_groups;

#define LAS __attribute__((address_space(3)))
typedef unsigned short bf16_t;
typedef short bf16x8 __attribute__((ext_vector_type(8)));
typedef float f32x4 __attribute__((ext_vector_type(4)));
typedef float f32x2 __attribute__((ext_vector_type(2)));
typedef unsigned u32x4 __attribute__((ext_vector_type(4)));
typedef unsigned u32x2 __attribute__((ext_vector_type(2)));

constexpr int MP = 16384, MT = 81920;
constexpr int DM = 1024, DFF = 2816, NGU = 2 * DFF;
constexpr int NCH = MT / 16;
constexpr float EPS = 1e-6f;

constexpr size_t MiB = 1u << 20;
constexpr size_t WS_WIN = 0, WS_WQKV = 3 * MiB, WS_WOUT = 6 * MiB, WS_WO = 8 * MiB, WS_WGLU = 10 * MiB;
constexpr size_t WS_WGU0 = 11 * MiB, WS_WGU1 = 22 * MiB, WS_WD0 = 33 * MiB, WS_WD1 = 39 * MiB;
constexpr size_t WS_B1 = 45 * MiB, WS_B3 = 53 * MiB, WS_AT = 61 * MiB, WS_BIAS = 61 * MiB + 65536;
constexpr size_t WS_R1 = 64 * MiB;
constexpr size_t WS_R2 = 224 * MiB;
constexpr size_t WS_A2 = WS_R2, WS_UB = WS_R2 + 160 * MiB, WS_VB = WS_R2 + 240 * MiB, WS_E = WS_R2 + 320 * MiB;
constexpr size_t WS_BAR = 63 * MiB + 512 * 1024;
constexpr size_t WS_SSQ = 62 * MiB;
constexpr size_t WS_XB = WS_R2 + 480 * MiB;
constexpr size_t WS_YG = WS_E + 80 * MiB;
constexpr size_t WS_END = WS_XB + 160 * MiB;

__device__ __forceinline__ int fresh_tid() { int t = threadIdx.x; asm volatile("" : "+v"(t)); return t; }
__device__ __forceinline__ unsigned cvt_pk_bf16(float lo, float hi) { unsigned r; asm volatile("v_cvt_pk_bf16_f32 %0, %1, %2" : "=v"(r) : "v"(lo), "v"(hi)); return r; }
__device__ __forceinline__ float bf_lo(unsigned w) { return __uint_as_float(w << 16); }
__device__ __forceinline__ float bf_hi(unsigned w) { return __uint_as_float(w & 0xffff0000u); }
__device__ __forceinline__ float sigmoid_f(float x) { return __builtin_amdgcn_rcpf(1.0f + __expf(-x)); }
__device__ __forceinline__ float gelu_f(float v) { const float t = 1.5957691216057308f * (v + 0.044715f * v * v * v); return v * sigmoid_f(t); }

namespace pg8 {
constexpr int BM = 256, BK = 64, HALF = 128, HTB = HALF * BK * 2, STAGE_BYTES = 8 * HTB, NXCD = 8, WGM = 4;
__host__ __device__ __forceinline__ int lds_byte(int r, int c) { const int st = (r >> 4) * 2 + (c >> 5), rr = r & 15, cc = c & 31, ob = rr * 64 + cc * 2; return st * 1024 + (ob ^ (((ob >> 9) & 1) << 5)); }
__host__ __device__ __forceinline__ void stage_rc(int b, int& R, int& C) { const int st = b / 1024, sb = b % 1024, swz = sb ^ (((sb >> 9) & 1) << 5); R = (st >> 1) * 16 + swz / 64; C = (st & 1) * 32 + (swz % 64) / 2; }
__host__ __device__ __forceinline__ int perm32(int rho) { const int n = rho >> 4, i = rho & 15; return 8 * (i >> 2) + 4 * n + (i & 3); }

struct Unit { int pm, pn; };
struct Gemm { const bf16_t* A; const bf16_t* Bt; int K, lda, ldb; unsigned kstepA, tstepA; int amode; };

struct StaticOrder {
    int nM, nN, nwg, G, c; bool rev;
    __device__ void init(int M, int N, int G_, int c_, bool rev_ = false) { nM = M / BM; nN = N / BM; nwg = nM * nN; G = G_; c = c_; rev = rev_; }
    __device__ bool next(int i, Unit& u) const {
        const long L = (long)i * G + c; if (L >= nwg) return false;
        int wgid = (int)L; { const int q = nwg / NXCD, r = nwg % NXCD, xcd = wgid % NXCD, off = wgid / NXCD; wgid = (xcd < r ? xcd * (q + 1) : r * (q + 1) + (xcd - r) * q) + off; }
        const int nig = WGM * nN, gid = wgid / nig, fm = gid * WGM, gsz = (nM - fm) < WGM ? (nM - fm) : WGM;
        u.pm = fm + ((wgid % nig) % gsz); u.pn = (wgid % nig) / gsz; if (rev) u.pm = nM - 1 - u.pm; return true;
    }
};
struct GroupedOrder {
    int G, c;
    __device__ bool next(int i, Unit& u) const { const int L = i * G + c; if (L >= 640) return false; u.pm = L; u.pn = L / 20; return true; }
};

template <class Epi, class Sched>
__device__ __forceinline__ void gemm_phase(LAS unsigned char* lds, const Gemm g, const Sched& S, const Epi& E) {
    const int tid = fresh_tid(), wid = __builtin_amdgcn_readfirstlane(tid >> 6), lane = tid & 63, wr = wid >> 2, wc = wid & 3, fr = lane & 15, fq = lane >> 4;
    const int K = g.K, nt = K / BK;
    unsigned voffA[2], voffB[2];
#pragma unroll
    for (int i = 0; i < 2; ++i) { int R, C; stage_rc(tid * 16 + i * 8192, R, C); const int Rb = Epi::PERM ? ((R & ~31) + perm32(R & 31)) : R;
        voffA[i] = (unsigned)(R * g.lda + (g.amode ? ((C >> 4) * (NCH * 256) + (C & 15)) : C)) * 2u; voffB[i] = (unsigned)(Rb * g.ldb + C) * 2u; }
    const size_t kstep = (size_t)(BK * 2); const size_t kA = g.kstepA ? (size_t)g.kstepA : kstep;
    const size_t hA = (size_t)HALF * g.lda * 2, hB = (size_t)HALF * g.ldb * 2;
    const size_t tA = g.tstepA ? (size_t)g.tstepA : 2 * hA, tB = 2 * hB;
    const unsigned ldsw = (unsigned)wid * 1024u;
    const int aoff = lds_byte(wr * 64 + fr, fq * 8), boff = lds_byte(wc * 32 + fr, fq * 8);
#define PG8_SA(b, h) (((b) * 2 + (h)) * HTB)
#define PG8_SB(b, h) ((4 + (b) * 2 + (h)) * HTB)
#define PG8_STAGE(bufoff, gbase, voff) do { _Pragma("unroll") for (int _i = 0; _i < 2; ++_i) \
        __builtin_amdgcn_global_load_lds((const unsigned*)((const char*)(gbase) + (voff)[_i]), (LAS unsigned*)(lds + (bufoff) + ldsw + _i * 8192), 16, 0, 0); } while (0)
#define PG8_LDA(dst, b, h) do { _Pragma("unroll") for (int m = 0; m < 4; ++m) _Pragma("unroll") for (int k = 0; k < 2; ++k) dst[m][k] = *(const LAS bf16x8*)(lds + PG8_SA(b, h) + aoff + m * 2048 + k * 1024); } while (0)
#define PG8_LDB(dst, b, h) do { _Pragma("unroll") for (int n = 0; n < 2; ++n) _Pragma("unroll") for (int k = 0; k < 2; ++k) dst[n][k] = *(const LAS bf16x8*)(lds + PG8_SB(b, h) + boff + n * 2048 + k * 1024); } while (0)
#define PG8_MMA(ai, bj, At, Bt) do { __builtin_amdgcn_s_setprio(1); _Pragma("unroll") for (int m = 0; m < 4; ++m) _Pragma("unroll") for (int n = 0; n < 2; ++n) _Pragma("unroll") for (int k = 0; k < 2; ++k) \
        acc[ai][bj][m][n] = __builtin_amdgcn_mfma_f32_16x16x32_bf16(Bt[n][k], At[m][k], acc[ai][bj][m][n], 0, 0, 0); __builtin_amdgcn_s_setprio(0); } while (0)
#define PG8_WAIT_V(n) asm volatile("s_waitcnt vmcnt(" #n ")" ::: "memory")
#define PG8_WAIT_L(n) asm volatile("s_waitcnt lgkmcnt(" #n ")" ::: "memory")
#define PG8_BAR __builtin_amdgcn_s_barrier()
#define PG8_SCHED __builtin_amdgcn_sched_barrier(0)
    Unit cur, nxt; int ui = 0;
    if (!S.next(0, cur)) return;
    f32x4 acc[2][2][4][2];
#pragma unroll
    for (int a = 0; a < 2; ++a)
#pragma unroll
        for (int b = 0; b < 2; ++b)
#pragma unroll
            for (int m = 0; m < 4; ++m)
#pragma unroll
                for (int n = 0; n < 2; ++n) acc[a][b][m][n] = (f32x4){0.f, 0.f, 0.f, 0.f};
    bf16x8 At[4][2], B0[2][2], B1[2][2];
    const char* cA = (const char*)g.A + (size_t)cur.pm * tA; const char* cB = (const char*)g.Bt + (size_t)cur.pn * tB;
    PG8_STAGE(PG8_SB(0, 0), cB, voffB); PG8_STAGE(PG8_SB(0, 1), cB + hB, voffB); PG8_STAGE(PG8_SA(0, 0), cA, voffA); PG8_STAGE(PG8_SA(0, 1), cA + hA, voffA);
    if (wr == 1) PG8_BAR;
    PG8_WAIT_V(2); PG8_BAR;
    PG8_STAGE(PG8_SB(1, 0), cB + kstep, voffB); PG8_STAGE(PG8_SA(1, 0), cA + kA, voffA); PG8_STAGE(PG8_SB(1, 1), cB + hB + kstep, voffB);
    PG8_WAIT_V(6); PG8_BAR;
    for (;;) {
        const bool has_next = S.next(ui + 1, nxt);
        const char* nA = has_next ? (const char*)g.A + (size_t)nxt.pm * tA : cA; const char* nB = has_next ? (const char*)g.Bt + (size_t)nxt.pn * tB : cB;
        for (int t = 0; t < nt; t += 2) {
            const bool last = (t == nt - 2);
            const char* a1 = cA + (size_t)(t + 1) * kA;
            const char* a2 = last ? nA : cA + (size_t)(t + 2) * kA; const char* b2 = last ? nB : cB + (size_t)(t + 2) * kstep;
            const char* a3 = a2 + kA; const char* b3 = b2 + kstep;
            PG8_LDB(B0, 0, 0); PG8_LDB(B1, 0, 1); PG8_SCHED; PG8_LDA(At, 0, 0); PG8_STAGE(PG8_SA(1, 1), a1 + hA, voffA);
            PG8_WAIT_V(8); PG8_WAIT_L(0); PG8_BAR; PG8_MMA(0, 0, At, B0); PG8_MMA(0, 1, At, B1); PG8_BAR; PG8_SCHED;
            PG8_LDA(At, 0, 1); PG8_STAGE(PG8_SB(0, 0), b2, voffB); PG8_STAGE(PG8_SB(0, 1), b2 + hB, voffB); PG8_STAGE(PG8_SA(0, 0), a2, voffA);
            PG8_WAIT_V(8); PG8_WAIT_L(0); PG8_BAR; PG8_MMA(1, 0, At, B0); PG8_MMA(1, 1, At, B1); PG8_BAR; PG8_SCHED;
            PG8_LDB(B0, 1, 0); PG8_LDB(B1, 1, 1); PG8_SCHED; PG8_LDA(At, 1, 0); PG8_STAGE(PG8_SA(0, 1), a2 + hA, voffA);
            PG8_WAIT_V(8); PG8_WAIT_L(0); PG8_BAR; PG8_MMA(0, 0, At, B0); PG8_MMA(0, 1, At, B1); PG8_BAR; PG8_SCHED;
            PG8_LDA(At, 1, 1); PG8_STAGE(PG8_SB(1, 0), b3, voffB); PG8_STAGE(PG8_SB(1, 1), b3 + hB, voffB); PG8_STAGE(PG8_SA(1, 0), a3, voffA);
            PG8_WAIT_V(8); PG8_WAIT_L(0); PG8_BAR; PG8_MMA(1, 0, At, B0); PG8_MMA(1, 1, At, B1); PG8_BAR; PG8_SCHED;
        }
        if (wr == 0) PG8_BAR;
        E(acc, cur, wr, wc, fr, fq);
        if (!has_next) break;
#pragma unroll
        for (int a = 0; a < 2; ++a)
#pragma unroll
            for (int b = 0; b < 2; ++b)
#pragma unroll
                for (int m = 0; m < 4; ++m)
#pragma unroll
                    for (int n = 0; n < 2; ++n) acc[a][b][m][n] = (f32x4){0.f, 0.f, 0.f, 0.f};
        cur = nxt; cA = nA; cB = nB; ++ui;
        if (wr == 1) PG8_BAR;
    }
    PG8_WAIT_V(0);
    PG8_BAR;
#undef PG8_SA
#undef PG8_SB
#undef PG8_STAGE
#undef PG8_LDA
#undef PG8_LDB
#undef PG8_MMA
#undef PG8_WAIT_V
#undef PG8_WAIT_L
#undef PG8_BAR
#undef PG8_SCHED
}

typedef f32x4 Acc[2][2][4][2];

struct EpiIn {
    static constexpr bool PERM = true;
    bf16_t* A2; bf16_t* UB; bf16_t* VB;
    __device__ __forceinline__ void operator()(const Acc& acc, const Unit& u, int wr, int wc, int fr, int fq) const {
        const int row0 = u.pm * BM + wr * 64 + fr; const int part = u.pn >> 1;
#pragma unroll
        for (int ai = 0; ai < 2; ++ai)
#pragma unroll
            for (int m = 0; m < 4; ++m) { const int row = row0 + ai * HALF + m * 16;
#pragma unroll
                for (int bj = 0; bj < 2; ++bj) { const int col = u.pn * BM + bj * HALF + wc * 32 + 8 * fq;
                    f32x4 v0 = acc[ai][bj][m][0], v1 = acc[ai][bj][m][1]; bf16_t* dst;
                    if (part == 0) { const int g = col >> 4, h0 = col & 15, bc = row >> 4, j = row & 15; dst = A2 + ((size_t)(g * NCH + bc) * 512 + j * 16 + h0); }
                    else { for (int e = 0; e < 4; ++e) { v0[e] = gelu_f(v0[e]); v1[e] = gelu_f(v1[e]); } dst = (part == 1 ? UB : VB) + (size_t)row * 512 + (col - 512 * part); }
                    u32x4 w; w.x = cvt_pk_bf16(v0[0], v0[1]); w.y = cvt_pk_bf16(v0[2], v0[3]); w.z = cvt_pk_bf16(v1[0], v1[1]); w.w = cvt_pk_bf16(v1[2], v1[3]);
                    *(u32x4*)dst = w; } }
    }
};
struct EpiE {
    static constexpr bool PERM = false;
    bf16_t* E;
    __device__ __forceinline__ void operator()(const Acc& acc, const Unit& u, int wr, int wc, int fr, int fq) const {
        const bool odd = fq & 1;
#pragma unroll
        for (int ai = 0; ai < 2; ++ai)
#pragma unroll
            for (int m = 0; m < 4; ++m) { bf16_t* rp = E + (size_t)(u.pm * BM + ai * HALF + wr * 64 + m * 16 + fr) * 256 + wc * 32 + (odd ? 16 + 4 * (fq - 1) : 4 * fq);
#pragma unroll
                for (int bj = 0; bj < 2; ++bj) { const f32x4 v0 = acc[ai][bj][m][0], v1 = acc[ai][bj][m][1];
                    const unsigned a0 = cvt_pk_bf16(v0[0], v0[1]), a1 = cvt_pk_bf16(v0[2], v0[3]), b0 = cvt_pk_bf16(v1[0], v1[1]), b1 = cvt_pk_bf16(v1[2], v1[3]);
                    const unsigned r0 = __shfl_xor(odd ? a0 : b0, 16), r1 = __shfl_xor(odd ? a1 : b1, 16);
                    u32x4 w; if (odd) { w.x = r0; w.y = r1; w.z = b0; w.w = b1; } else { w.x = a0; w.y = a1; w.z = r0; w.w = r1; }
                    *(u32x4*)(rp + bj * HALF) = w; } }
    }
};
struct EpiS3 {
    static constexpr bool PERM = true;
    bf16_t* YG;
    __device__ __forceinline__ void operator()(const Acc& acc, const Unit& u, int wr, int wc, int fr, int fq) const {
        const int g = u.pn;
#pragma unroll
        for (int ai = 0; ai < 2; ++ai)
#pragma unroll
            for (int m = 0; m < 4; ++m) { const int bc = u.pm * BM + ai * HALF + wr * 64 + m * 16 + fr - g * NCH;
#pragma unroll
                for (int bj = 0; bj < 2; ++bj) { const int n0 = bj * HALF + wc * 32 + 8 * fq, i = n0 >> 4, hp = n0 & 15;
                    f32x4 v0 = acc[ai][bj][m][0], v1 = acc[ai][bj][m][1];
                    for (int e = 0; e < 4; ++e) { v0[e] = gelu_f(v0[e]); v1[e] = gelu_f(v1[e]); }
                    u32x4 w; w.x = cvt_pk_bf16(v0[0], v0[1]); w.y = cvt_pk_bf16(v0[2], v0[3]); w.z = cvt_pk_bf16(v1[0], v1[1]); w.w = cvt_pk_bf16(v1[2], v1[3]);
                    *(u32x4*)(YG + (size_t)(g * NCH + bc) * 256 + n0) = w; } }
    }
};
struct EpiGlu {
    static constexpr bool PERM = true;
    const bf16_t* YG; const float* bias; bf16_t* YAB;
    __device__ __forceinline__ void operator()(const Acc& acc, const Unit& u, int wr, int wc, int fr, int fq) const {
        const int row0 = u.pm * BM + wr * 64 + fr;
#pragma unroll
        for (int ai = 0; ai < 2; ++ai)
#pragma unroll
            for (int m = 0; m < 4; ++m) { const int row = row0 + ai * HALF + m * 16;
#pragma unroll
                for (int bj = 0; bj < 2; ++bj) { const int col = u.pn * BM + bj * HALF + wc * 32 + 8 * fq;
                    const u32x4 yv = *(const u32x4*)(YG + (size_t)(col >> 4) * (NCH * 256) + (size_t)row * 16 + (col & 15));
                    const f32x4 b0 = *(const f32x4*)(bias + col), b1 = *(const f32x4*)(bias + col + 4);
                    const f32x4 v0 = acc[ai][bj][m][0] + b0, v1 = acc[ai][bj][m][1] + b1;
                    u32x4 w;
                    w.x = cvt_pk_bf16(bf_lo(yv.x) * sigmoid_f(v0[0]), bf_hi(yv.x) * sigmoid_f(v0[1]));
                    w.y = cvt_pk_bf16(bf_lo(yv.y) * sigmoid_f(v0[2]), bf_hi(yv.y) * sigmoid_f(v0[3]));
                    w.z = cvt_pk_bf16(bf_lo(yv.z) * sigmoid_f(v1[0]), bf_hi(yv.z) * sigmoid_f(v1[1]));
                    w.w = cvt_pk_bf16(bf_lo(yv.w) * sigmoid_f(v1[2]), bf_hi(yv.w) * sigmoid_f(v1[3]));
                    *(u32x4*)(YAB + (size_t)row * 1024 + col) = w; } }
    }
};
template <int MODE> struct EpiRes {
    static constexpr bool PERM = true;
    const float* base0; const float* base1; float* out; bf16_t* XB; float* ssq;
    __device__ __forceinline__ void operator()(const Acc& acc, const Unit& u, int wr, int wc, int fr, int fq) const {
        const int row0 = u.pm * BM + wr * 64 + fr; const int col0 = u.pn * BM + wc * 32 + 8 * fq;
        const float* bp = (MODE == 0) ? ((u.pm < MP / BM) ? base0 : base1) : nullptr;
#pragma unroll
        for (int ai = 0; ai < 2; ++ai) {
            f32x4 bv[4][2][2];
#pragma unroll
            for (int m = 0; m < 4; ++m) { const size_t off = (size_t)(row0 + ai * HALF + m * 16) * DM + col0;
#pragma unroll
                for (int bj = 0; bj < 2; ++bj) {
                    if (MODE == 0) { bv[m][bj][0] = *(const f32x4*)(bp + off + bj * HALF); bv[m][bj][1] = *(const f32x4*)(bp + off + bj * HALF + 4); }
                    else if (MODE == 3) { const u32x4 xv = *(const u32x4*)(XB + off + bj * HALF); const float rn = sqrtf(base1[row0 + ai * HALF + m * 16] * (1.f / DM) + EPS);
                        bv[m][bj][0] = (f32x4){bf_lo(xv.x), bf_hi(xv.x), bf_lo(xv.y), bf_hi(xv.y)} * rn; bv[m][bj][1] = (f32x4){bf_lo(xv.z), bf_hi(xv.z), bf_lo(xv.w), bf_hi(xv.w)} * rn; }
                    else { const u32x4 xv = *(const u32x4*)(XB + off + bj * HALF); bv[m][bj][0] = (f32x4){bf_lo(xv.x), bf_hi(xv.x), bf_lo(xv.y), bf_hi(xv.y)}; bv[m][bj][1] = (f32x4){bf_lo(xv.z), bf_hi(xv.z), bf_lo(xv.w), bf_hi(xv.w)}; } } }
            asm volatile("" ::: "memory");
#pragma unroll
            for (int m = 0; m < 4; ++m) { const int row = row0 + ai * HALF + m * 16; const size_t off = (size_t)row * DM + col0; float sq = 0.f;
#pragma unroll
                for (int bj = 0; bj < 2; ++bj) {
                    const f32x4 o0 = bv[m][bj][0] + acc[ai][bj][m][0], o1 = bv[m][bj][1] + acc[ai][bj][m][1];
                    if (MODE == 2) { *(f32x4*)(out + off + bj * HALF) = o0; *(f32x4*)(out + off + bj * HALF + 4) = o1; }
                    else { sq += ((o0[0] * o0[0] + o0[1] * o0[1]) + (o0[2] * o0[2] + o0[3] * o0[3])) + ((o1[0] * o1[0] + o1[1] * o1[1]) + (o1[2] * o1[2] + o1[3] * o1[3]));
                        u32x4 w; w.x = cvt_pk_bf16(o0[0], o0[1]); w.y = cvt_pk_bf16(o0[2], o0[3]); w.z = cvt_pk_bf16(o1[0], o1[1]); w.w = cvt_pk_bf16(o1[2], o1[3]); *(u32x4*)(XB + off + bj * HALF) = w; } }
                if (MODE != 2) { sq += __shfl_xor(sq, 16); sq += __shfl_xor(sq, 32); if (fq == 0) unsafeAtomicAdd(ssq + row, sq); } }
            asm volatile("" ::: "memory"); }
    }
};
struct EpiSwiglu {
    static constexpr bool PERM = true;
    bf16_t* HB; const float* ssq;
    __device__ __forceinline__ void operator()(const Acc& acc, const Unit& u, int wr, int wc, int fr, int fq) const {
        const int row0 = u.pm * BM + wr * 64 + fr;
#pragma unroll
        for (int ai = 0; ai < 2; ++ai)
#pragma unroll
            for (int m = 0; m < 4; ++m) { const int row = row0 + ai * HALF + m * 16; bf16_t* rp = HB + (size_t)row * DFF + u.pn * HALF + wc * 32 + 8 * fq;
                const float rstd = rsqrtf(ssq[row] * (1.f / DM) + EPS);
                u32x4 w;
#pragma unroll
                for (int bj = 0; bj < 2; ++bj) { const f32x4 gt = acc[ai][bj][m][0] * rstd, up = acc[ai][bj][m][1] * rstd;
                    f32x4 e = gt * (-1.4426950408889634f);
#pragma unroll
                    for (int q = 0; q < 4; ++q) e[q] = __builtin_amdgcn_exp2f(e[q]);
                    e = e + 1.0f;
#pragma unroll
                    for (int q = 0; q < 4; ++q) e[q] = __builtin_amdgcn_rcpf(e[q]);
                    const f32x4 o = gt * e * up;
                    if (bj == 0) { w.x = cvt_pk_bf16(o[0], o[1]); w.y = cvt_pk_bf16(o[2], o[3]); } else { w.z = cvt_pk_bf16(o[0], o[1]); w.w = cvt_pk_bf16(o[2], o[3]); } }
                *(u32x4*)rp = w; }
    }
};
struct EpiBf16 {
    static constexpr bool PERM = true;
    bf16_t* O; int ldc; const float* ssq;
    __device__ __forceinline__ void operator()(const Acc& acc, const Unit& u, int wr, int wc, int fr, int fq) const {
        const int row0 = u.pm * BM + wr * 64 + fr; const int col0 = u.pn * BM + wc * 32 + 8 * fq;
#pragma unroll
        for (int ai = 0; ai < 2; ++ai)
#pragma unroll
            for (int m = 0; m < 4; ++m) { const int row = row0 + ai * HALF + m * 16; bf16_t* rp = O + (size_t)row * ldc + col0;
                const float rstd = rsqrtf(ssq[row] * (1.f / DM) + EPS);
#pragma unroll
                for (int bj = 0; bj < 2; ++bj) { const f32x4 v0 = acc[ai][bj][m][0] * rstd, v1 = acc[ai][bj][m][1] * rstd;
                    u32x4 w; w.x = cvt_pk_bf16(v0[0], v0[1]); w.y = cvt_pk_bf16(v0[2], v0[3]); w.z = cvt_pk_bf16(v1[0], v1[1]); w.w = cvt_pk_bf16(v1[2], v1[3]);
                    *(u32x4*)(rp + bj * HALF) = w; } }
    }
};
}

constexpr int LDS_BYTES = 147456;
struct Args { const float* in[28]; float* out; unsigned char* ws; };

__device__ __forceinline__ float wave_sum(float v) {
#pragma unroll
    for (int o = 1; o < 64; o <<= 1) v += __shfl_xor(v, o);
    return v;
}

__device__ __forceinline__ void transpose_item(const float* W, int K, int N, bf16_t* WT, int mode, float* scr, int item, int lane, const float* ksc = nullptr) {
    const int nblk = N / 32, kb = item / nblk, nb = item % nblk, k0 = 64 * kb, n0 = 32 * nb;
#pragma unroll 8
    for (int i = 0; i < 32; ++i) { const int kk = 2 * i + (lane >> 5); const float sc = ksc ? ksc[k0 + kk] : 1.0f; scr[kk * 33 + (lane & 31)] = W[(size_t)(k0 + kk) * N + n0 + (lane & 31)] * sc; }
    asm volatile("s_waitcnt lgkmcnt(0)" ::: "memory");
    const int c = lane & 7;
#pragma unroll
    for (int j = 0; j < 4; ++j) { const int nl = (lane >> 3) + 8 * j; const float* s = scr + (8 * c) * 33 + nl; const int n = n0 + nl;
        const int row = mode == 0 ? n : (256 * (n >> 7) + 128 * ((n >> 2) & 1) + 32 * ((n >> 5) & 3) + 8 * ((n >> 3) & 3) + (mode == 2 ? 4 : 0) + (n & 3));
        u32x4 o; o.x = cvt_pk_bf16(s[0 * 33], s[1 * 33]); o.y = cvt_pk_bf16(s[2 * 33], s[3 * 33]); o.z = cvt_pk_bf16(s[4 * 33], s[5 * 33]); o.w = cvt_pk_bf16(s[6 * 33], s[7 * 33]);
        *(u32x4*)(WT + (size_t)row * K + k0 + 8 * c) = o; }
    asm volatile("s_waitcnt lgkmcnt(0)" ::: "memory");
}

__device__ __forceinline__ void rms_rows(const float* src0, const float* src1, const float* gw_, bf16_t* XN, float* ssq) {
    if (blockIdx.x < 32) return;
    const int tid = fresh_tid(), lane = tid & 63, gw = (blockIdx.x - 32) * 8 + (tid >> 6), NGW = (gridDim.x - 32) * 8;
    int m = gw; f32x4 v[4];
    if (m < MT) { const f32x4* xr = (const f32x4*)((m < MP) ? src0 + (size_t)m * DM : src1 + (size_t)(m - MP) * DM) + lane;
#pragma unroll
        for (int j = 0; j < 4; ++j) v[j] = __builtin_nontemporal_load(xr + 64 * j); }
    for (; m < MT; m += NGW) {
        const int m2 = m + NGW; f32x4 nv[4];
        if (m2 < MT) { const f32x4* xr = (const f32x4*)((m2 < MP) ? src0 + (size_t)m2 * DM : src1 + (size_t)(m2 - MP) * DM) + lane;
#pragma unroll
            for (int j = 0; j < 4; ++j) nv[j] = __builtin_nontemporal_load(xr + 64 * j); }
        float s = 0.f;
#pragma unroll
        for (int j = 0; j < 4; ++j) s += (v[j].x * v[j].x + v[j].y * v[j].y) + (v[j].z * v[j].z + v[j].w * v[j].w);
        s = wave_sum(s); if (lane == 0) ssq[m] = s;
        const float rstd = rsqrtf(s * (1.f / DM) + EPS);
        u32x2* o8 = (u32x2*)(XN + (size_t)m * DM) + lane;
#pragma unroll
        for (int j = 0; j < 4; ++j) { u32x2 w; w.x = cvt_pk_bf16(v[j].x * rstd, v[j].y * rstd); w.y = cvt_pk_bf16(v[j].z * rstd, v[j].w * rstd); o8[64 * j] = w; }
        if (m2 < MT) {
#pragma unroll
            for (int j = 0; j < 4; ++j) v[j] = nv[j]; }
    }
}

__device__ __forceinline__ void s5_prep(const Args& a, int g, unsigned char* lds) {
    const int tid = fresh_tid();
    f32x2* apow = (f32x2*)lds;
    f32x2* bbar = apow + 2 * 17 * 64;
    f32x2* zt = bbar + 2 * 64 * 16;
    float* kmat = (float*)(zt + 128);
    const float* lam_re = a.in[5]; const float* lam_im = a.in[6]; const float* log_dt = a.in[7];
    const float* b_re = a.in[8]; const float* b_im = a.in[9]; const float* c_re = a.in[10]; const float* c_im = a.in[11]; const float* d_skip = a.in[12];
    bf16_t* B1 = (bf16_t*)(a.ws + WS_B1) + (size_t)g * 256 * 512;
    bf16_t* B3 = (bf16_t*)(a.ws + WS_B3) + (size_t)g * 256 * 512;
    f32x2* AT = (f32x2*)(a.ws + WS_AT);
    if (tid < 128) {
        const int dir = tid >> 6, p = tid & 63; const int idx = (dir * 32 + g) * 64 + p;
        const float lr = lam_re[idx], li = lam_im[idx], dt = expf(log_dt[dir * 32 + g]);
        for (int k = 0; k <= 16; ++k) { const float mg = expf(lr * dt * (float)k), ang = li * dt * (float)k; apow[(dir * 17 + k) * 64 + p] = (f32x2){mg * cosf(ang), mg * sinf(ang)}; }
        const f32x2 a1 = apow[(dir * 17 + 1) * 64 + p]; const float den = lr * lr + li * li;
        zt[dir * 64 + p] = (f32x2){((a1.x - 1.0f) * lr + a1.y * li) / den, (a1.y * lr - (a1.x - 1.0f) * li) / den};
        AT[idx] = apow[(dir * 17 + 16) * 64 + p];
    }
    __syncthreads();
    for (int e = tid; e < 2048; e += 512) { const int dir = e >> 10, p = (e >> 4) & 63, h = e & 15; const size_t gi = ((size_t)(dir * 32 + g) * 64 + p) * 16 + h;
        const float br = b_re[gi], bi = b_im[gi]; const f32x2 z = zt[dir * 64 + p]; bbar[e] = (f32x2){z.x * br - z.y * bi, z.x * bi + z.y * br}; }
    __syncthreads();
    for (int e = tid; e < 31 * 256; e += 512) { const int lag = e / 256 - 15, hp = (e >> 4) & 15, h = e & 15; float sum = 0.f;
        if (lag >= 0) { const size_t ci = ((size_t)(0 * 32 + g) * 16 + hp) * 64;
            for (int p = 0; p < 64; ++p) { const float cr = c_re[ci + p], cim = c_im[ci + p]; const f32x2 aw = apow[(0 * 17 + lag) * 64 + p]; const f32x2 b = bbar[(0 * 64 + p) * 16 + h];
                const float wr_ = cr * aw.x - cim * aw.y, wi_ = cr * aw.y + cim * aw.x; sum += wr_ * b.x - wi_ * b.y; } }
        if (lag <= 0) { const size_t ci = ((size_t)(1 * 32 + g) * 16 + hp) * 64;
            for (int p = 0; p < 64; ++p) { const float cr = c_re[ci + p], cim = c_im[ci + p]; const f32x2 aw = apow[(1 * 17 - lag) * 64 + p]; const f32x2 b = bbar[(1 * 64 + p) * 16 + h];
                const float wr_ = cr * aw.x - cim * aw.y, wi_ = cr * aw.y + cim * aw.x; sum += wr_ * b.x - wi_ * b.y; } }
        if (lag == 0 && hp == h) sum += d_skip[g * 16 + h];
        kmat[e] = sum; }
    __syncthreads();
    for (int e = tid; e < 256 * 256; e += 512) { const int n = e >> 8, k = (e & 255) * 2; const int i = n >> 4, hp = n & 15; float v0, v1;
        if (k < 256) { const int j = k >> 4, h = k & 15; const float* kp = kmat + (i - j + 15) * 256 + hp * 16 + h; v0 = kp[0]; v1 = kp[1]; }
        else { const int kk = k - 256, dir = kk >> 7, p = (kk >> 1) & 63; const int ee = dir == 0 ? i + 1 : 16 - i; const size_t ci = ((size_t)(dir * 32 + g) * 16 + hp) * 64 + p;
            const float cr = c_re[ci], cim = c_im[ci]; const f32x2 aw = apow[(dir * 17 + ee) * 64 + p]; v0 = cr * aw.x - cim * aw.y; v1 = -(cr * aw.y + cim * aw.x); }
        *(unsigned*)(B3 + (size_t)n * 512 + k) = cvt_pk_bf16(v0, v1); }
    for (int e = tid; e < 256 * 128; e += 512) { const int n = e >> 7, k = (e & 127) * 2; const int dir = n >> 7, p = (n >> 1) & 63, ri = n & 1, j = k >> 4, h = k & 15;
        const int ee = dir == 0 ? 15 - j : j; const f32x2 aw = apow[(dir * 17 + ee) * 64 + p]; const f32x2 b0 = bbar[(dir * 64 + p) * 16 + h], b1 = bbar[(dir * 64 + p) * 16 + h + 1];
        const float v0 = ri ? (aw.x * b0.y + aw.y * b0.x) : (aw.x * b0.x - aw.y * b0.y), v1 = ri ? (aw.x * b1.y + aw.y * b1.x) : (aw.x * b1.x - aw.y * b1.y);
        *(unsigned*)(B1 + (size_t)n * 512 + k) = cvt_pk_bf16(v0, v1); }
    __syncthreads();
}

__device__ __forceinline__ void sg_phase(const Args& a, unsigned char* lds) {
    const int tid = fresh_tid();
    bf16_t* VT = (bf16_t*)lds;
    const bf16_t* VB = (const bf16_t*)(a.ws + WS_VB); const bf16_t* UB = (const bf16_t*)(a.ws + WS_UB); bf16_t* YAB = (bf16_t*)(a.ws + WS_R1);
    const int lane = tid & 63, w = tid >> 6, fr = lane & 15, fq = lane >> 4;
    const int G = gridDim.x; int u = blockIdx.x;
    const int ch = tid & 15, j0 = tid >> 4;
    u32x4 vreg[4];
    if (u < 2560) {
#pragma unroll
        for (int it = 0; it < 4; ++it) vreg[it] = *(const u32x4*)(VB + ((size_t)(u >> 2) * 128 + j0 + 32 * it) * 512 + (u & 3) * 128 + ch * 8); }
    for (; u < 2560; u += G) { const int n = u >> 2, h = u & 3;
        const float* gmn = a.in[15] + h * 128; const float* Ws = a.in[16] + (size_t)h * 128 * 128; const float* bs = a.in[17] + h * 128;
        const int i = 16 * w + fr; const size_t tok = (size_t)n * 128 + i;
        u32x4 ub[4];
#pragma unroll
        for (int q = 0; q < 4; ++q) ub[q] = *(const u32x4*)(UB + tok * 512 + h * 128 + 32 * fq + 8 * q);
        f32x4 wv[4][2];
#pragma unroll
        for (int ks = 0; ks < 4; ++ks) { wv[ks][0] = *(const f32x4*)(Ws + (size_t)i * 128 + ks * 32 + fq * 8); wv[ks][1] = *(const f32x4*)(Ws + (size_t)i * 128 + ks * 32 + fq * 8 + 4); }
        const float bsv = bs[i];
        const f32x4 g0 = *(const f32x4*)(gmn + ch * 8), g1 = *(const f32x4*)(gmn + ch * 8 + 4);
        const float gg[8] = {g0.x, g0.y, g0.z, g0.w, g1.x, g1.y, g1.z, g1.w};
#pragma unroll
        for (int it = 0; it < 4; ++it) { const int j = j0 + 32 * it; const u32x4 v = vreg[it];
            float f[8] = {bf_lo(v.x), bf_hi(v.x), bf_lo(v.y), bf_hi(v.y), bf_lo(v.z), bf_hi(v.z), bf_lo(v.w), bf_hi(v.w)};
            float ss = 0.f;
#pragma unroll
            for (int e = 0; e < 8; ++e) ss += f[e] * f[e];
            ss += __shfl_xor(ss, 1); ss += __shfl_xor(ss, 2); ss += __shfl_xor(ss, 4); ss += __shfl_xor(ss, 8);
            const float rstd = rsqrtf(ss * (1.f / 128.f) + EPS);
#pragma unroll
            for (int e = 0; e < 8; e += 2) { const unsigned pk = cvt_pk_bf16(f[e] * rstd * gg[e], f[e + 1] * rstd * gg[e + 1]);
                const int d = ch * 8 + e, r0 = 16 * ((d >> 2) & 7) + 4 * (d >> 5) + (d & 3);
                VT[r0 * 136 + j] = (bf16_t)(pk & 0xffffu); VT[(r0 + 1) * 136 + j] = (bf16_t)(pk >> 16); } }
        __syncthreads();
        if (u + G < 2560) { const int u2 = u + G;
#pragma unroll
            for (int it = 0; it < 4; ++it) vreg[it] = *(const u32x4*)(VB + ((size_t)(u2 >> 2) * 128 + j0 + 32 * it) * 512 + (u2 & 3) * 128 + ch * 8); }
        bf16x8 bw[4];
#pragma unroll
        for (int ks = 0; ks < 4; ++ks) { const f32x4 w0 = wv[ks][0], w1 = wv[ks][1];
            u32x4 pk; pk.x = cvt_pk_bf16(w0.x, w0.y); pk.y = cvt_pk_bf16(w0.z, w0.w); pk.z = cvt_pk_bf16(w1.x, w1.y); pk.w = cvt_pk_bf16(w1.z, w1.w); bw[ks] = __builtin_bit_cast(bf16x8, pk); }
        f32x4 acc[8];
#pragma unroll
        for (int mt = 0; mt < 8; ++mt) { acc[mt] = (f32x4){0.f, 0.f, 0.f, 0.f};
#pragma unroll
            for (int ks = 0; ks < 4; ++ks) { const bf16x8 av = *(const bf16x8*)(VT + (mt * 16 + fr) * 136 + ks * 32 + fq * 8); acc[mt] = __builtin_amdgcn_mfma_f32_16x16x32_bf16(av, bw[ks], acc[mt], 0, 0, 0); } }
#pragma unroll
        for (int q = 0; q < 4; ++q) { const f32x4 a0 = acc[2 * q] + bsv, a1 = acc[2 * q + 1] + bsv; const u32x4 uv = ub[q]; u32x4 o;
            o.x = cvt_pk_bf16(bf_lo(uv.x) * a0[0], bf_hi(uv.x) * a0[1]); o.y = cvt_pk_bf16(bf_lo(uv.y) * a0[2], bf_hi(uv.y) * a0[3]);
            o.z = cvt_pk_bf16(bf_lo(uv.z) * a1[0], bf_hi(uv.z) * a1[1]); o.w = cvt_pk_bf16(bf_lo(uv.w) * a1[2], bf_hi(uv.w) * a1[3]);
            *(u32x4*)(YAB + tok * 1024 + 512 + h * 128 + 32 * fq + 8 * q) = o; }
        __syncthreads();
    }
}

__device__ __forceinline__ void scan_unit(const Args& a, int unit, int t) {
    const int s = unit >> 5, g = unit & 31; const int nc = s < 4 ? 256 : 512; const int bc0 = s < 4 ? s * 256 : 1024 + (s - 4) * 512;
    const int dir = t >> 6, p = t & 63;
    const f32x2 aT = ((const f32x2*)(a.ws + WS_AT))[(dir * 32 + g) * 64 + p];
    const bf16_t* E = (const bf16_t*)(a.ws + WS_E) + ((size_t)(g * NCH + bc0) * 256 + 2 * t);
    bf16_t* A2 = (bf16_t*)(a.ws + WS_A2) + ((size_t)(g * NCH + bc0) * 512 + 256 + 2 * t);
    float sr = 0.f, si = 0.f;
    for (int c0 = 0; c0 < nc; c0 += 32) {
        unsigned ev[32];
#pragma unroll
        for (int q = 0; q < 32; ++q) { const int c = dir == 0 ? c0 + q : nc - 1 - c0 - q; ev[q] = *(const unsigned*)(E + (size_t)c * 256); }
#pragma unroll
        for (int q = 0; q < 32; ++q) { const int c = dir == 0 ? c0 + q : nc - 1 - c0 - q;
            *(unsigned*)(A2 + (size_t)c * 512) = cvt_pk_bf16(sr, si);
            const float nr = aT.x * sr - aT.y * si + bf_lo(ev[q]), ni = aT.x * si + aT.y * sr + bf_hi(ev[q]); sr = nr; si = ni; }
    }
}

constexpr int KP = 72, VP = 408;
__device__ __forceinline__ void attn_unit(const Args& a, int s, int qb, int kvh, bool cont, unsigned char* lds) {
    const int tid = fresh_tid();
    bf16_t* Kl = (bf16_t*)lds;
    bf16_t* VT = Kl + 400 * KP;
    float* biasL = (float*)(VT + 64 * VP);
    const bf16_t* QKV = (const bf16_t*)(a.ws + WS_R2); bf16_t* O = (bf16_t*)(a.ws + WS_R1);
    const float* qn = a.in[20]; const float* kn = a.in[21]; const float* sinkp = a.in[22]; const float* BIAS = (const float*)(a.ws + WS_BIAS);
    const int L = s < 4 ? 4096 : 8192; const size_t rowbase = s < 4 ? (size_t)s * 4096 : (size_t)MP + (size_t)(s - 4) * 8192;
    const int q0 = qb * 128; const int lane = tid & 63, w = tid >> 6, fr = lane & 15, fq = lane >> 4;
    const bf16_t* qbase = QKV + (rowbase + q0 + (w & 1) * 64 + fr) * 1536 + (kvh * 4 + (w >> 1)) * 64 + fq * 8;
    u32x4 qn0 = *(const u32x4*)qbase, qn1 = *(const u32x4*)(qbase + 32), qn2 = *(const u32x4*)(qbase + 16 * 1536), qn3 = *(const u32x4*)(qbase + 16 * 1536 + 32);
    const int k_lo = cont ? 256 : 0, npieces = (384 - k_lo) * 8;
    u32x4 kvr[6], vvr[6];
#pragma unroll
    for (int it = 0; it < 6; ++it) { const int piece = tid + 512 * it; const int kk = k_lo + (piece >> 3), ch = piece & 7; const int kpos = q0 - 128 + kk; const bool valid = piece < npieces && kpos >= 0 && kpos < L;
        kvr[it] = (u32x4){0u, 0u, 0u, 0u}; vvr[it] = (u32x4){0u, 0u, 0u, 0u};
        if (valid) { const bf16_t* rp = QKV + (rowbase + kpos) * 1536 + kvh * 64 + ch * 8; kvr[it] = *(const u32x4*)(rp + 1024); vvr[it] = *(const u32x4*)(rp + 1280); } }
    const f32x4 g0 = *(const f32x4*)(kn + (tid & 7) * 8), g1 = *(const f32x4*)(kn + (tid & 7) * 8 + 4);
#pragma unroll
    for (int it = 0; it < 6; ++it) { const int piece = tid + 512 * it; const int kk = k_lo + (piece >> 3), ch = piece & 7;
        if (piece < npieces) { const int slot = (q0 + 256 + kk) % 384;
        const u32x4 kv = kvr[it], vv = vvr[it];
        float f[8] = {bf_lo(kv.x), bf_hi(kv.x), bf_lo(kv.y), bf_hi(kv.y), bf_lo(kv.z), bf_hi(kv.z), bf_lo(kv.w), bf_hi(kv.w)};
        float ss = 0.f;
#pragma unroll
        for (int e = 0; e < 8; ++e) ss += f[e] * f[e];
        ss += __shfl_xor(ss, 1); ss += __shfl_xor(ss, 2); ss += __shfl_xor(ss, 4);
        const float rstd = rsqrtf(ss * (1.f / 64.f) + EPS);
        u32x4 o; o.x = cvt_pk_bf16(f[0] * rstd * g0.x, f[1] * rstd * g0.y); o.y = cvt_pk_bf16(f[2] * rstd * g0.z, f[3] * rstd * g0.w);
        o.z = cvt_pk_bf16(f[4] * rstd * g1.x, f[5] * rstd * g1.y); o.w = cvt_pk_bf16(f[6] * rstd * g1.z, f[7] * rstd * g1.w);
        *(u32x4*)(Kl + slot * KP + ch * 8) = o;
        const unsigned vw[4] = {vv.x, vv.y, vv.z, vv.w};
#pragma unroll
        for (int e = 0; e < 4; ++e) { const int d0 = ch * 8 + 2 * e, r0 = ((d0 >> 2) & 3) * 16 + (d0 >> 4) * 4 + (d0 & 3);
            VT[r0 * VP + slot] = (bf16_t)(vw[e] & 0xffffu); VT[(r0 + 1) * VP + slot] = (bf16_t)(vw[e] >> 16); } } }
    if (!cont)
    for (int idx = tid; idx < 4 * 304; idx += 512) { const int hq = idx / 304, ii = idx % 304 - 16; biasL[idx] = (ii >= 0 && ii <= 256) ? BIAS[(kvh * 4 + hq) * 257 + ii] : 0.f; }
    __syncthreads();
    const int hq = w >> 1, H = kvh * 4 + hq; const float sink = sinkp[H] * 1.4426950408889634f; const bool edge = (q0 == 0) || (q0 + 128 == L);
    const float* bl = biasL + hq * 304 + 16;
#define MAKE_QF(R0, R1, QF) { const u32x4 r0 = R0, r1 = R1; \
          float f[16] = {bf_lo(r0.x), bf_hi(r0.x), bf_lo(r0.y), bf_hi(r0.y), bf_lo(r0.z), bf_hi(r0.z), bf_lo(r0.w), bf_hi(r0.w), bf_lo(r1.x), bf_hi(r1.x), bf_lo(r1.y), bf_hi(r1.y), bf_lo(r1.z), bf_hi(r1.z), bf_lo(r1.w), bf_hi(r1.w)}; \
          float ss = 0.f; \
          _Pragma("unroll") for (int e = 0; e < 16; ++e) ss += f[e] * f[e]; \
          ss += __shfl_xor(ss, 16); ss += __shfl_xor(ss, 32); \
          const float rstd = rsqrtf(ss * (1.f / 64.f) + EPS) * (0.125f * 1.4426950408889634f); \
          u32x4 p0, p1; \
          p0.x = cvt_pk_bf16(f[0] * rstd * qg[0].x, f[1] * rstd * qg[0].y); p0.y = cvt_pk_bf16(f[2] * rstd * qg[0].z, f[3] * rstd * qg[0].w); \
          p0.z = cvt_pk_bf16(f[4] * rstd * qg[1].x, f[5] * rstd * qg[1].y); p0.w = cvt_pk_bf16(f[6] * rstd * qg[1].z, f[7] * rstd * qg[1].w); \
          p1.x = cvt_pk_bf16(f[8] * rstd * qg[2].x, f[9] * rstd * qg[2].y); p1.y = cvt_pk_bf16(f[10] * rstd * qg[2].z, f[11] * rstd * qg[2].w); \
          p1.z = cvt_pk_bf16(f[12] * rstd * qg[3].x, f[13] * rstd * qg[3].y); p1.w = cvt_pk_bf16(f[14] * rstd * qg[3].z, f[15] * rstd * qg[3].w); \
          QF[0] = __builtin_bit_cast(bf16x8, p0); QF[1] = __builtin_bit_cast(bf16x8, p1); }
#pragma unroll 1
    for (int pr = 0; pr < 2; ++pr) { const int qs = (w & 1) * 64 + pr * 32;
        bf16x8 qfA[2], qfB[2];
        { f32x4 qg[4];
#pragma unroll
          for (int e = 0; e < 2; ++e) { qg[2 * e] = *(const f32x4*)(qn + e * 32 + fq * 8); qg[2 * e + 1] = *(const f32x4*)(qn + e * 32 + fq * 8 + 4); }
          MAKE_QF(qn0, qn1, qfA) MAKE_QF(qn2, qn3, qfB) }
        f32x4 SA[18], SB[18];
        const int base0 = (q0 + 256 + qs) % 384;
        const LAS unsigned char* kb3 = (const LAS unsigned char*)(Kl + fr * KP + fq * 8); const LAS unsigned char* bb3 = (const LAS unsigned char*)(bl + 4 * fq - fr);
        const LAS unsigned char* vb3 = (const LAS unsigned char*)(VT + fr * VP + 4 * fq);
        {   bf16x8 kf[2][2]; f32x4 bi[2]; f32x4 bprev = {0.f, 0.f, 0.f, 0.f};
#define LDK(buf, kt) { const int sl_ = base0 + 16 * (kt) - ((base0 + 16 * (kt) >= 384) ? 384 : 0); const LAS unsigned char* kp_ = kb3 + sl_ * (KP * 2); \
                _Pragma("unroll") for (int ks = 0; ks < 2; ++ks) kf[buf][ks] = *(const LAS bf16x8*)(kp_ + ks * 64); \
                if ((kt) < 17) { _Pragma("unroll") for (int r = 0; r < 4; ++r) bi[buf][r] = *(const LAS float*)(bb3 + ((kt) * 16 + r) * 4); } }
            LDK(0, 0)
#pragma unroll
            for (int kt = 0; kt < 18; ++kt) {
                if (kt < 17) { LDK((kt + 1) & 1, kt + 1) }
                __builtin_amdgcn_sched_barrier(0);
                if (kt < 17) { f32x4 acc = bi[kt & 1];
                    acc = __builtin_amdgcn_mfma_f32_16x16x32_bf16(kf[kt & 1][0], qfA[0], acc, 0, 0, 0); acc = __builtin_amdgcn_mfma_f32_16x16x32_bf16(kf[kt & 1][1], qfA[1], acc, 0, 0, 0); SA[kt] = acc; }
                if (kt >= 1) { f32x4 acc = bprev;
                    acc = __builtin_amdgcn_mfma_f32_16x16x32_bf16(kf[kt & 1][0], qfB[0], acc, 0, 0, 0); acc = __builtin_amdgcn_mfma_f32_16x16x32_bf16(kf[kt & 1][1], qfB[1], acc, 0, 0, 0); SB[kt] = acc; }
                if (kt < 17) bprev = bi[kt & 1];
                __builtin_amdgcn_sched_barrier(0);
            }
#undef LDK
        }
        u32x2 vf[1][4][2];
#define LDV(buf, kp) { const int cl_ = base0 + 32 * (kp) - ((base0 + 32 * (kp) >= 384) ? 384 : 0); const LAS unsigned char* vp_ = vb3 + cl_ * 2; \
        _Pragma("unroll") for (int dt = 0; dt < 4; ++dt) { vf[buf][dt][0] = *(const LAS u32x2*)(vp_ + (dt * 16 * VP) * 2); vf[buf][dt][1] = *(const LAS u32x2*)(vp_ + (dt * 16 * VP + 16) * 2); } }
#pragma unroll
        for (int r = 0; r < 4; ++r) { if (4 * fq + r - fr < 0) { SA[0][r] = -1e30f; SB[1][r] = -1e30f; } if (4 * fq + r - fr > 0) { SA[16][r] = -1e30f; SB[17][r] = -1e30f; } }
        if (edge) {
#pragma unroll
            for (int kt = 0; kt < 18; ++kt)
#pragma unroll
                for (int r = 0; r < 4; ++r) { const int kpos = q0 - 128 + qs + kt * 16 + 4 * fq + r; if (kpos < 0 || kpos >= L) { if (kt < 17) SA[kt][r] = -1e30f; if (kt >= 1) SB[kt][r] = -1e30f; } } }
        float invA, invB;
        {   float mx = sink;
#pragma unroll
            for (int kt = 0; kt < 17; ++kt)
#pragma unroll
                for (int r = 0; r < 4; ++r) mx = fmaxf(mx, SA[kt][r]);
            mx = fmaxf(mx, __shfl_xor(mx, 16)); mx = fmaxf(mx, __shfl_xor(mx, 32));
            f32x4 sumv = {0.f, 0.f, 0.f, 0.f}; const f32x4 mxv = {mx, mx, mx, mx};
#pragma unroll
            for (int kt = 0; kt < 17; ++kt) { f32x4 d = SA[kt] - mxv;
#pragma unroll
                for (int r = 0; r < 4; ++r) d[r] = __builtin_amdgcn_exp2f(d[r]);
                SA[kt] = d; sumv += d; }
            float sum = (sumv[0] + sumv[1]) + (sumv[2] + sumv[3]);
            sum += __shfl_xor(sum, 16); sum += __shfl_xor(sum, 32); sum += __builtin_amdgcn_exp2f(sink - mx);
            invA = 1.0f / sum; SA[17] = (f32x4){0.f, 0.f, 0.f, 0.f}; }
        {   float mx = sink;
#pragma unroll
            for (int kt = 1; kt < 18; ++kt)
#pragma unroll
                for (int r = 0; r < 4; ++r) mx = fmaxf(mx, SB[kt][r]);
            mx = fmaxf(mx, __shfl_xor(mx, 16)); mx = fmaxf(mx, __shfl_xor(mx, 32));
            f32x4 sumv = {0.f, 0.f, 0.f, 0.f}; const f32x4 mxv = {mx, mx, mx, mx};
#pragma unroll
            for (int kt = 1; kt < 18; ++kt) { f32x4 d = SB[kt] - mxv;
#pragma unroll
                for (int r = 0; r < 4; ++r) d[r] = __builtin_amdgcn_exp2f(d[r]);
                SB[kt] = d; sumv += d; }
            float sum = (sumv[0] + sumv[1]) + (sumv[2] + sumv[3]);
            sum += __shfl_xor(sum, 16); sum += __shfl_xor(sum, 32); sum += __builtin_amdgcn_exp2f(sink - mx);
            invB = 1.0f / sum; SB[0] = (f32x4){0.f, 0.f, 0.f, 0.f}; }
        f32x4 OcA[4], OcB[4];
#pragma unroll
        for (int dt = 0; dt < 4; ++dt) { OcA[dt] = (f32x4){0.f, 0.f, 0.f, 0.f}; OcB[dt] = (f32x4){0.f, 0.f, 0.f, 0.f}; }
#pragma unroll
        for (int kp = 0; kp < 9; ++kp) {
            LDV(0, kp)
            u32x4 pa, pb_;
            pa.x = cvt_pk_bf16(SA[2 * kp][0], SA[2 * kp][1]); pa.y = cvt_pk_bf16(SA[2 * kp][2], SA[2 * kp][3]); pa.z = cvt_pk_bf16(SA[2 * kp + 1][0], SA[2 * kp + 1][1]); pa.w = cvt_pk_bf16(SA[2 * kp + 1][2], SA[2 * kp + 1][3]);
            pb_.x = cvt_pk_bf16(SB[2 * kp][0], SB[2 * kp][1]); pb_.y = cvt_pk_bf16(SB[2 * kp][2], SB[2 * kp][3]); pb_.z = cvt_pk_bf16(SB[2 * kp + 1][0], SB[2 * kp + 1][1]); pb_.w = cvt_pk_bf16(SB[2 * kp + 1][2], SB[2 * kp + 1][3]);
            const bf16x8 pA = __builtin_bit_cast(bf16x8, pa), pB = __builtin_bit_cast(bf16x8, pb_);
#pragma unroll
            for (int dt = 0; dt < 4; ++dt) { u32x4 av; av.x = vf[0][dt][0].x; av.y = vf[0][dt][0].y; av.z = vf[0][dt][1].x; av.w = vf[0][dt][1].y;
                const bf16x8 avf = __builtin_bit_cast(bf16x8, av);
                OcA[dt] = __builtin_amdgcn_mfma_f32_16x16x32_bf16(avf, pA, OcA[dt], 0, 0, 0); OcB[dt] = __builtin_amdgcn_mfma_f32_16x16x32_bf16(avf, pB, OcB[dt], 0, 0, 0); }
            __builtin_amdgcn_sched_barrier(0);
        }
#undef LDV
        { u32x4 o0, o1;
          o0.x = cvt_pk_bf16(OcA[0][0] * invA, OcA[0][1] * invA); o0.y = cvt_pk_bf16(OcA[0][2] * invA, OcA[0][3] * invA); o0.z = cvt_pk_bf16(OcA[1][0] * invA, OcA[1][1] * invA); o0.w = cvt_pk_bf16(OcA[1][2] * invA, OcA[1][3] * invA);
          o1.x = cvt_pk_bf16(OcA[2][0] * invA, OcA[2][1] * invA); o1.y = cvt_pk_bf16(OcA[2][2] * invA, OcA[2][3] * invA); o1.z = cvt_pk_bf16(OcA[3][0] * invA, OcA[3][1] * invA); o1.w = cvt_pk_bf16(OcA[3][2] * invA, OcA[3][3] * invA);
          bf16_t* op = O + (unsigned)(((unsigned)rowbase + q0 + qs + fr) * 1024u + H * 64 + 16 * fq); *(u32x4*)op = o0; *(u32x4*)(op + 8) = o1;
          o0.x = cvt_pk_bf16(OcB[0][0] * invB, OcB[0][1] * invB); o0.y = cvt_pk_bf16(OcB[0][2] * invB, OcB[0][3] * invB); o0.z = cvt_pk_bf16(OcB[1][0] * invB, OcB[1][1] * invB); o0.w = cvt_pk_bf16(OcB[1][2] * invB, OcB[1][3] * invB);
          o1.x = cvt_pk_bf16(OcB[2][0] * invB, OcB[2][1] * invB); o1.y = cvt_pk_bf16(OcB[2][2] * invB, OcB[2][3] * invB); o1.z = cvt_pk_bf16(OcB[3][0] * invB, OcB[3][1] * invB); o1.w = cvt_pk_bf16(OcB[3][2] * invB, OcB[3][3] * invB);
          op += 16 * 1024; *(u32x4*)op = o0; *(u32x4*)(op + 8) = o1; }
        if (pr == 0) { const bf16_t* qb2 = QKV + (unsigned)(((unsigned)rowbase + q0 + (w & 1) * 64 + 32 + fr) * 1536u + (kvh * 4 + (w >> 1)) * 64 + fq * 8);
            qn0 = *(const u32x4*)qb2; qn1 = *(const u32x4*)(qb2 + 32); qn2 = *(const u32x4*)(qb2 + 16 * 1536); qn3 = *(const u32x4*)(qb2 + 16 * 1536 + 32); }
    }
#undef MAKE_QF
    __syncthreads();
}

__device__ __forceinline__ int rel_bucket(int rel) {
    const int n = rel < 0 ? -rel : rel; int ret = rel > 0 ? 16 : 0;
    int large = 8; if (n >= 8) { const unsigned q = (unsigned)(n * n) >> 6; large = 8 + (31 - __builtin_clz(q)); } if (large > 15) large = 15;
    return ret + (n < 8 ? n : large);
}

#define XB_TMO      128
#define XB_XCNT(j)  (256  + 64 * (j))
#define XB_XSUB(j)  (1280 + 64 * (j))
#define XB_XGEN(j)  (2304 + 64 * (j))
#define XB_TOP      3328
#define XB_TOPGEN   3392
#define XCD_BAR_WORDS 3456
#define XB_SPIN_CAP (1u << 22)

__device__ __forceinline__ unsigned xb_ld(unsigned* p)              { return __hip_atomic_load(p, __ATOMIC_RELAXED, __HIP_MEMORY_SCOPE_AGENT); }
__device__ __forceinline__ unsigned xb_add(unsigned* p, unsigned v) { return __hip_atomic_fetch_add(p, v, __ATOMIC_RELAXED, __HIP_MEMORY_SCOPE_AGENT); }
__device__ __forceinline__ unsigned xb_xcc_id() { return (unsigned)__builtin_amdgcn_s_getreg((3 << 11) | 20) & 0xFu; }
#define XB_SPIN(cond, bar) do { unsigned _sp = 0; while (cond) { __builtin_amdgcn_s_sleep(1); \
    if ((++_sp & 255u) == 0u) { if (xb_ld(&(bar)[XB_TMO])) break; if (_sp > XB_SPIN_CAP) { atomicAdd(&(bar)[XB_TMO], 1u); break; } } } } while (0)

struct XcdBarrier {
    unsigned* bar; unsigned x;
    volatile LAS unsigned* st;
};

__device__ __forceinline__ XcdBarrier xcd_barrier_post(unsigned* bar, volatile LAS unsigned* st) {
    XcdBarrier b; b.bar = bar; b.x = xb_xcc_id(); b.st = st;
    if (threadIdx.x == 0) (void)xb_add(&bar[XB_XCNT(b.x)], 1u);
    return b;
}
__device__ __forceinline__ void xcd_barrier_complete(unsigned* bar, unsigned x, unsigned& nloc, unsigned& nx) {
    const unsigned G = gridDim.x * gridDim.y * gridDim.z;
    unsigned sum, cnt, mine, sp = 0u;
    for (;;) {
        sum = 0u; cnt = 0u; mine = 0u;
#pragma unroll
        for (unsigned j = 0; j < 16; ++j) { const unsigned c = xb_ld(&bar[XB_XCNT(j)]); sum += c; cnt += (c > 0u) ? 1u : 0u; mine = (j == x) ? c : mine; }
        if (sum == G) break;
        __builtin_amdgcn_s_sleep(1);
        if ((++sp & 255u) == 0u) { if (xb_ld(&bar[XB_TMO])) break; if (sp > XB_SPIN_CAP) { atomicAdd(&bar[XB_TMO], 1u); break; } }
    }
    nloc = mine > 0u ? mine : 1u; nx = cnt > 0u ? cnt : 1u;
}

__device__ __forceinline__ void xcd_barrier(const XcdBarrier& b) {
    asm volatile("s_waitcnt vmcnt(0)" ::: "memory");
    __syncthreads();
    if (threadIdx.x == 0) {
        unsigned* bar = b.bar;
        __builtin_amdgcn_s_waitcnt(0);
        unsigned nloc = b.st[0], nx = b.st[1];
        if (nloc == 0u) { xcd_barrier_complete(bar, b.x, nloc, nx); b.st[0] = nloc; b.st[1] = nx; }
        const unsigned old = xb_add(&bar[XB_XSUB(b.x)], 1u);
        const unsigned gen = old / nloc;
        if (old + 1u == (gen + 1u) * nloc) {
            __builtin_amdgcn_fence(__ATOMIC_RELEASE, "agent");
            asm volatile("s_waitcnt vmcnt(0)" ::: "memory");
            const unsigned og = xb_add(&bar[XB_TOP], 1u);
            const unsigned tg = og / nx;
            if (og + 1u == (tg + 1u) * nx) xb_add(&bar[XB_TOPGEN], 1u);
            else XB_SPIN(xb_ld(&bar[XB_TOPGEN]) == tg, bar);
            __builtin_amdgcn_fence(__ATOMIC_ACQUIRE, "agent");
            xb_add(&bar[XB_XGEN(b.x)], 1u);
            asm volatile("s_waitcnt vmcnt(0)" ::: "memory");
        } else {
            XB_SPIN(xb_ld(&bar[XB_XGEN(b.x)]) == gen, bar);
            __builtin_amdgcn_fence(__ATOMIC_ACQUIRE, "agent");
            asm volatile("s_waitcnt vmcnt(0)" ::: "memory");
        }
    }
    __syncthreads();
}

__global__ void __launch_bounds__(512, 2) fwd_kernel(Args a) {
    extern __shared__ __attribute__((aligned(16))) unsigned char lds[];
    cg::grid_group grid = cg::this_grid();
    LAS unsigned char* lds3 = (LAS unsigned char*)lds;
    const int G = gridDim.x, bx = blockIdx.x;
    unsigned char* ws = a.ws;
    volatile LAS unsigned* bst = (volatile LAS unsigned*)(lds3 + 131072 + 64);
    { const int t0 = fresh_tid(); if (t0 < 2) bst[t0] = 0u;
      if (bx == 0) for (int e = t0; e < XCD_BAR_WORDS; e += 512) ((unsigned*)(ws + WS_BAR))[e] = 0u; }
    __syncthreads();

    #ifndef NO_S5P
    if (bx < 32) s5_prep(a, bx, lds);
#endif
    {
        const int tid = fresh_tid(), lane = tid & 63, wave = tid >> 6, gw = bx * 8 + wave, NGW = G * 8;
        float* scr = (float*)(lds + wave * 16384);
        constexpr int I_IN = 16 * 48, I_GLU = 8 * 16, I_OUT = 16 * 32, I_QKV = 16 * 48, I_O = 16 * 32, I_G = 16 * 88, I_D = 44 * 32;
        constexpr int NITEMS = I_IN + I_GLU + I_OUT + I_QKV + I_O + 4 * I_G + 2 * I_D;
        for (int it = gw; it < NITEMS; it += NGW) {
            int r = it;
            if (r < I_IN) { transpose_item(a.in[4], 1024, 1536, (bf16_t*)(ws + WS_WIN), 0, scr, r, lane, a.in[2]); continue; } r -= I_IN;
            if (r < I_GLU) { transpose_item(a.in[13], 512, 512, (bf16_t*)(ws + WS_WGLU), 0, scr, r, lane); continue; } r -= I_GLU;
            if (r < I_OUT) { transpose_item(a.in[18], 1024, 1024, (bf16_t*)(ws + WS_WOUT), 0, scr, r, lane); continue; } r -= I_OUT;
            if (r < I_QKV) { transpose_item(a.in[19], 1024, 1536, (bf16_t*)(ws + WS_WQKV), 0, scr, r, lane, a.in[2] + DM); continue; } r -= I_QKV;
            if (r < I_O) { transpose_item(a.in[23], 1024, 1024, (bf16_t*)(ws + WS_WO), 0, scr, r, lane); continue; } r -= I_O;
            if (r < 4 * I_G) { const int l = r / (2 * I_G), rr = r % (2 * I_G), up = rr / I_G, item = rr % I_G;
                transpose_item(a.in[up ? 26 : 25] + (size_t)l * 1024 * DFF, 1024, DFF, (bf16_t*)(ws + (l ? WS_WGU1 : WS_WGU0)), up ? 2 : 1, scr, item, lane, a.in[3] + l * DM); continue; } r -= 4 * I_G;
            { const int l = r / I_D, item = r % I_D; transpose_item(a.in[27] + (size_t)l * DFF * 1024, DFF, 1024, (bf16_t*)(ws + (l ? WS_WD1 : WS_WD0)), 0, scr, item, lane); }
        }
        for (int e = bx * 512 + tid; e < 16 * 257; e += G * 512) { const int h = e / 257, rel = e % 257 - 128; ((float*)(ws + WS_BIAS))[e] = a.in[24][rel_bucket(rel) * 16 + h] * 1.4426950408889634f; }
        for (int e = bx * 512 + tid; e < 3 * MT; e += G * 512) ((float*)(ws + WS_SSQ))[e] = 0.f;
        rms_rows(a.in[0], a.in[1], a.in[2], (bf16_t*)(ws + WS_XB), (float*)(ws + WS_SSQ) + 3 * MT);
    }
    grid.sync();
    const XcdBarrier xbar = xcd_barrier_post((unsigned*)(ws + WS_BAR), bst);

    { constexpr int layer = 0;
        if constexpr (layer == 0) {
            { pg8::Gemm g{(const bf16_t*)(ws + WS_XB), (const bf16_t*)(ws + WS_WIN), 1024, 1024, 1024, 0, 0, 0}; pg8::StaticOrder S; S.init(MT, 1536, G, bx);
              pg8::EpiIn E{(bf16_t*)(ws + WS_A2), (bf16_t*)(ws + WS_UB), (bf16_t*)(ws + WS_VB)};
              pg8::gemm_phase(lds3, g, S, E); }
            xcd_barrier(xbar);
            { pg8::Gemm g{(const bf16_t*)(ws + WS_A2), (const bf16_t*)(ws + WS_B1), 256, 512, 512, 0, 0, 0}; pg8::GroupedOrder S{G, bx};
              pg8::EpiE E{(bf16_t*)(ws + WS_E)};
              pg8::gemm_phase(lds3, g, S, E); }
            __syncthreads();
#ifndef NO_SG
            sg_phase(a, lds);
#endif
            xcd_barrier(xbar);
            { const int tid_ = fresh_tid(); const int sub = tid_ >> 7, t = tid_ & 127; const int unit = sub * G + bx;
#ifndef NO_SCAN
              if (unit < 384) scan_unit(a, unit, t);
#endif
            }
            xcd_barrier(xbar);
            { pg8::Gemm g{(const bf16_t*)(ws + WS_A2), (const bf16_t*)(ws + WS_B3), 512, 512, 512, 0, 0, 0}; pg8::GroupedOrder S{G, bx};
              pg8::EpiS3 E{(bf16_t*)(ws + WS_YG)};
              pg8::gemm_phase(lds3, g, S, E); }
            xcd_barrier(xbar);
            { pg8::Gemm g{(const bf16_t*)(ws + WS_YG), (const bf16_t*)(ws + WS_WGLU), 512, 16, 512, 4u * NCH * 256u * 2u, 256u * 16u * 2u, 1}; pg8::StaticOrder S; S.init(MT, 512, G, bx);
              pg8::EpiGlu E{(const bf16_t*)(ws + WS_YG), a.in[14], (bf16_t*)(ws + WS_R1)};
              pg8::gemm_phase(lds3, g, S, E); }
            xcd_barrier(xbar);
        } else {
            { pg8::Gemm g{(const bf16_t*)(ws + WS_XB), (const bf16_t*)(ws + WS_WQKV), 1024, 1024, 1024, 0, 0, 0}; pg8::StaticOrder S; S.init(MT, 1536, G, bx);
              pg8::EpiBf16 E{(bf16_t*)(ws + WS_R2), 1536, (const float*)(ws + WS_SSQ) + MT};
              pg8::gemm_phase(lds3, g, S, E); }
            xcd_barrier(xbar);
            { const int u_lo = (int)((long)bx * 2560 / G), u_hi = (int)((long)(bx + 1) * 2560 / G); int pst = -1, pqb = -2;
              for (int U = u_lo; U < u_hi; ++U) { int st, qb; if (U < 512) { st = U >> 5; qb = U & 31; } else { st = 16 + ((U - 512) >> 6); qb = (U - 512) & 63; }
                const int s = st >> 2, kvh = st & 3; const bool cont = (st == pst) && (qb == pqb + 1); pst = st; pqb = qb;
                attn_unit(a, s, qb, kvh, cont, lds); } }
            xcd_barrier(xbar);
        }
        { pg8::Gemm g{(const bf16_t*)(ws + WS_R1), (const bf16_t*)(ws + (layer ? WS_WO : WS_WOUT)), 1024, 1024, 1024, 0, 0, 0}; pg8::StaticOrder S; S.init(MT, 1024, G, bx);
          if constexpr (layer == 0) { pg8::EpiRes<3> E{a.in[2], (const float*)(ws + WS_SSQ) + 3 * MT, nullptr, (bf16_t*)(ws + WS_XB), (float*)(ws + WS_SSQ)}; pg8::gemm_phase(lds3, g, S, E); }
          else { pg8::EpiRes<1> E{nullptr, nullptr, nullptr, (bf16_t*)(ws + WS_XB), (float*)(ws + WS_SSQ) + 2 * MT}; pg8::gemm_phase(lds3, g, S, E); } }
        xcd_barrier(xbar);
        { pg8::Gemm g{(const bf16_t*)(ws + WS_XB), (const bf16_t*)(ws + (layer ? WS_WGU1 : WS_WGU0)), 1024, 1024, 1024, 0, 0, 0}; pg8::StaticOrder S; S.init(MT, NGU, G, bx);
          pg8::EpiSwiglu E{(bf16_t*)(ws + WS_R2), (const float*)(ws + WS_SSQ) + (layer ? 2 * MT : 0)};
          pg8::gemm_phase(lds3, g, S, E); }
        xcd_barrier(xbar);
        { pg8::Gemm g{(const bf16_t*)(ws + WS_R2), (const bf16_t*)(ws + (layer ? WS_WD1 : WS_WD0)), DFF, DFF, DFF, 0, 0, 0}; pg8::StaticOrder S; S.init(MT, 1024, G, bx, true);
          if constexpr (layer == 0) { pg8::EpiRes<1> E{nullptr, nullptr, nullptr, (bf16_t*)(ws + WS_XB), (float*)(ws + WS_SSQ) + MT}; pg8::gemm_phase(lds3, g, S, E); xcd_barrier(xbar); }
          else { pg8::EpiRes<2> E{nullptr, nullptr, a.out, (bf16_t*)(ws + WS_XB), nullptr}; pg8::gemm_phase(lds3, g, S, E); } }
    }
    { constexpr int layer = 1;
        if constexpr (layer == 0) {
            { pg8::Gemm g{(const bf16_t*)(ws + WS_XB), (const bf16_t*)(ws + WS_WIN), 1024, 1024, 1024, 0, 0, 0}; pg8::StaticOrder S; S.init(MT, 1536, G, bx);
              pg8::EpiIn E{(bf16_t*)(ws + WS_A2), (bf16_t*)(ws + WS_UB), (bf16_t*)(ws + WS_VB)};
              pg8::gemm_phase(lds3, g, S, E); }
            xcd_barrier(xbar);
            { pg8::Gemm g{(const bf16_t*)(ws + WS_A2), (const bf16_t*)(ws + WS_B1), 256, 512, 512, 0, 0, 0}; pg8::GroupedOrder S{G, bx};
              pg8::EpiE E{(bf16_t*)(ws + WS_E)};
              pg8::gemm_phase(lds3, g, S, E); }
            __syncthreads();
#ifndef NO_SG
            sg_phase(a, lds);
#endif
            xcd_barrier(xbar);
            { const int tid_ = fresh_tid(); const int sub = tid_ >> 7, t = tid_ & 127; const int unit = sub * G + bx;
#ifndef NO_SCAN
              if (unit < 384) scan_unit(a, unit, t);
#endif
            }
            xcd_barrier(xbar);
            { pg8::Gemm g{(const bf16_t*)(ws + WS_A2), (const bf16_t*)(ws + WS_B3), 512, 512, 512, 0, 0, 0}; pg8::GroupedOrder S{G, bx};
              pg8::EpiS3 E{(bf16_t*)(ws + WS_YG)};
              pg8::gemm_phase(lds3, g, S, E); }
            xcd_barrier(xbar);
            { pg8::Gemm g{(const bf16_t*)(ws + WS_YG), (const bf16_t*)(ws + WS_WGLU), 512, 16, 512, 4u * NCH * 256u * 2u, 256u * 16u * 2u, 1}; pg8::StaticOrder S; S.init(MT, 512, G, bx);
              pg8::EpiGlu E{(const bf16_t*)(ws + WS_YG), a.in[14], (bf16_t*)(ws + WS_R1)};
              pg8::gemm_phase(lds3, g, S, E); }
            xcd_barrier(xbar);
        } else {
            { pg8::Gemm g{(const bf16_t*)(ws + WS_XB), (const bf16_t*)(ws + WS_WQKV), 1024, 1024, 1024, 0, 0, 0}; pg8::StaticOrder S; S.init(MT, 1536, G, bx);
              pg8::EpiBf16 E{(bf16_t*)(ws + WS_R2), 1536, (const float*)(ws + WS_SSQ) + MT};
              pg8::gemm_phase(lds3, g, S, E); }
            xcd_barrier(xbar);
            { const int u_lo = (int)((long)bx * 2560 / G), u_hi = (int)((long)(bx + 1) * 2560 / G); int pst = -1, pqb = -2;
              for (int U = u_lo; U < u_hi; ++U) { int st, qb; if (U < 512) { st = U >> 5; qb = U & 31; } else { st = 16 + ((U - 512) >> 6); qb = (U - 512) & 63; }
                const int s = st >> 2, kvh = st & 3; const bool cont = (st == pst) && (qb == pqb + 1); pst = st; pqb = qb;
                attn_unit(a, s, qb, kvh, cont, lds); } }
            xcd_barrier(xbar);
        }
        { pg8::Gemm g{(const bf16_t*)(ws + WS_R1), (const bf16_t*)(ws + (layer ? WS_WO : WS_WOUT)), 1024, 1024, 1024, 0, 0, 0}; pg8::StaticOrder S; S.init(MT, 1024, G, bx);
          if constexpr (layer == 0) { pg8::EpiRes<3> E{a.in[2], (const float*)(ws + WS_SSQ) + 3 * MT, nullptr, (bf16_t*)(ws + WS_XB), (float*)(ws + WS_SSQ)}; pg8::gemm_phase(lds3, g, S, E); }
          else { pg8::EpiRes<1> E{nullptr, nullptr, nullptr, (bf16_t*)(ws + WS_XB), (float*)(ws + WS_SSQ) + 2 * MT}; pg8::gemm_phase(lds3, g, S, E); } }
        xcd_barrier(xbar);
        { pg8::Gemm g{(const bf16_t*)(ws + WS_XB), (const bf16_t*)(ws + (layer ? WS_WGU1 : WS_WGU0)), 1024, 1024, 1024, 0, 0, 0}; pg8::StaticOrder S; S.init(MT, NGU, G, bx);
          pg8::EpiSwiglu E{(bf16_t*)(ws + WS_R2), (const float*)(ws + WS_SSQ) + (layer ? 2 * MT : 0)};
          pg8::gemm_phase(lds3, g, S, E); }
        xcd_barrier(xbar);
        { pg8::Gemm g{(const bf16_t*)(ws + WS_R2), (const bf16_t*)(ws + (layer ? WS_WD1 : WS_WD0)), DFF, DFF, DFF, 0, 0, 0}; pg8::StaticOrder S; S.init(MT, 1024, G, bx, true);
          if constexpr (layer == 0) { pg8::EpiRes<1> E{nullptr, nullptr, nullptr, (bf16_t*)(ws + WS_XB), (float*)(ws + WS_SSQ) + MT}; pg8::gemm_phase(lds3, g, S, E); xcd_barrier(xbar); }
          else { pg8::EpiRes<2> E{nullptr, nullptr, a.out, (bf16_t*)(ws + WS_XB), nullptr}; pg8::gemm_phase(lds3, g, S, E); } }
    }
}

extern "C" void kernel_launch(void* const* d_in, const int* in_sizes, int n_in, void* d_out, int out_size, void* d_ws, size_t ws_size, hipStream_t stream) {
    static int grid = 0;
    if (grid == 0) {
        if (n_in != 28 || out_size != MT * DM || ws_size < WS_END) { fprintf(stderr, "kernel_launch: unexpected shapes (n_in %d out %d ws %zu)\n", n_in, out_size, ws_size); grid = -1; return; }
        int dev = 0, cus = 0, per_cu = 0;
        hipGetDevice(&dev); hipDeviceGetAttribute(&cus, hipDeviceAttributeMultiprocessorCount, dev);
        hipFuncSetAttribute((const void*)fwd_kernel, hipFuncAttributeMaxDynamicSharedMemorySize, LDS_BYTES);
        hipOccupancyMaxActiveBlocksPerMultiprocessor(&per_cu, (const void*)fwd_kernel, 512, LDS_BYTES);
        if (per_cu < 1) per_cu = 1;
        grid = cus * per_cu;
        (void)hipGetLastError();
    }
    if (grid < 0) return;
    Args a{};
    for (int i = 0; i < 28; ++i) a.in[i] = (const float*)d_in[i];
    a.out = (float*)d_out; a.ws = (unsigned char*)d_ws;
    void* args[] = {&a};
    hipError_t e = hipLaunchCooperativeKernel((const void*)fwd_kernel, dim3(grid), dim3(512), args, LDS_BYTES, stream);
    if (e != hipSuccess) fprintf(stderr, "cooperative launch failed: %s (grid %d)\n", hipGetErrorString(e), grid);
}
```

```cpp
#include <hip/hip_runtime.h>
#include <hip/hip_cooperative_groups.h>
#include <cstdio>
#include <cstdint>
namespace cg = cooperative_groups;

#define LAS __attribute__((address_space(3)))
typedef unsigned short bf16_t;
typedef short bf16x8 __attribute__((ext_vector_type(8)));
typedef float f32x4 __attribute__((ext_vector_type(4)));
typedef float f32x2 __attribute__((ext_vector_type(2)));
typedef unsigned u32x4 __attribute__((ext_vector_type(4)));
typedef unsigned u32x2 __attribute__((ext_vector_type(2)));

constexpr int MP = 16384, MT = 81920;
constexpr int DM = 1024, DFF = 2816, NGU = 2 * DFF;
constexpr int NCH = MT / 16;
constexpr float EPS = 1e-6f;

constexpr size_t MiB = 1u << 20;
constexpr size_t WS_WIN = 0, WS_WQKV = 3 * MiB, WS_WOUT = 6 * MiB, WS_WO = 8 * MiB, WS_WGLU = 10 * MiB;
constexpr size_t WS_WGU0 = 11 * MiB, WS_WGU1 = 22 * MiB, WS_WD0 = 33 * MiB, WS_WD1 = 39 * MiB;
constexpr size_t WS_B1 = 45 * MiB, WS_B3 = 53 * MiB, WS_AT = 61 * MiB, WS_BIAS = 61 * MiB + 65536;
constexpr size_t WS_R1 = 64 * MiB;
constexpr size_t WS_R2 = 224 * MiB;
constexpr size_t WS_A2 = WS_R2, WS_UB = WS_R2 + 160 * MiB, WS_VB = WS_R2 + 240 * MiB, WS_E = WS_R2 + 320 * MiB;
constexpr size_t WS_BAR = 63 * MiB + 512 * 1024;
constexpr size_t WS_SSQ = 62 * MiB;
constexpr size_t WS_XB = WS_R2 + 480 * MiB;
constexpr size_t WS_YG = WS_E + 80 * MiB;
constexpr size_t WS_END = WS_XB + 160 * MiB;

__device__ __forceinline__ int fresh_tid() { int t = threadIdx.x; asm volatile("" : "+v"(t)); return t; }
__device__ __forceinline__ unsigned cvt_pk_bf16(float lo, float hi) { unsigned r; asm volatile("v_cvt_pk_bf16_f32 %0, %1, %2" : "=v"(r) : "v"(lo), "v"(hi)); return r; }
__device__ __forceinline__ float bf_lo(unsigned w) { return __uint_as_float(w << 16); }
__device__ __forceinline__ float bf_hi(unsigned w) { return __uint_as_float(w & 0xffff0000u); }
__device__ __forceinline__ float sigmoid_f(float x) { return __builtin_amdgcn_rcpf(1.0f + __expf(-x)); }
__device__ __forceinline__ float gelu_f(float v) { const float t = 1.5957691216057308f * (v + 0.044715f * v * v * v); return v * sigmoid_f(t); }

namespace pg8 {
constexpr int BM = 256, BK = 64, HALF = 128, HTB = HALF * BK * 2, STAGE_BYTES = 8 * HTB, NXCD = 8, WGM = 4;
__host__ __device__ __forceinline__ int lds_byte(int r, int c) { const int st = (r >> 4) * 2 + (c >> 5), rr = r & 15, cc = c & 31, ob = rr * 64 + cc * 2; return st * 1024 + (ob ^ (((ob >> 9) & 1) << 5)); }
__host__ __device__ __forceinline__ void stage_rc(int b, int& R, int& C) { const int st = b / 1024, sb = b % 1024, swz = sb ^ (((sb >> 9) & 1) << 5); R = (st >> 1) * 16 + swz / 64; C = (st & 1) * 32 + (swz % 64) / 2; }
__host__ __device__ __forceinline__ int perm32(int rho) { const int n = rho >> 4, i = rho & 15; return 8 * (i >> 2) + 4 * n + (i & 3); }

struct Unit { int pm, pn; };
struct Gemm { const bf16_t* A; const bf16_t* Bt; int K, lda, ldb; unsigned kstepA, tstepA; int amode; };

struct StaticOrder {
    int nM, nN, nwg, G, c; bool rev;
    __device__ void init(int M, int N, int G_, int c_, bool rev_ = false) { nM = M / BM; nN = N / BM; nwg = nM * nN; G = G_; c = c_; rev = rev_; }
    __device__ bool next(int i, Unit& u) const {
        const long L = (long)i * G + c; if (L >= nwg) return false;
        int wgid = (int)L; { const int q = nwg / NXCD, r = nwg % NXCD, xcd = wgid % NXCD, off = wgid / NXCD; wgid = (xcd < r ? xcd * (q + 1) : r * (q + 1) + (xcd - r) * q) + off; }
        const int nig = WGM * nN, gid = wgid / nig, fm = gid * WGM, gsz = (nM - fm) < WGM ? (nM - fm) : WGM;
        u.pm = fm + ((wgid % nig) % gsz); u.pn = (wgid % nig) / gsz; if (rev) u.pm = nM - 1 - u.pm; return true;
    }
};
struct GroupedOrder {
    int G, c;
    __device__ bool next(int i, Unit& u) const { const int L = i * G + c; if (L >= 640) return false; u.pm = L; u.pn = L / 20; return true; }
};

template <class Epi, class Sched>
__device__ __forceinline__ void gemm_phase(LAS unsigned char* lds, const Gemm g, const Sched& S, const Epi& E) {
    const int tid = fresh_tid(), wid = __builtin_amdgcn_readfirstlane(tid >> 6), lane = tid & 63, wr = wid >> 2, wc = wid & 3, fr = lane & 15, fq = lane >> 4;
    const int K = g.K, nt = K / BK;
    unsigned voffA[2], voffB[2];
#pragma unroll
    for (int i = 0; i < 2; ++i) { int R, C; stage_rc(tid * 16 + i * 8192, R, C); const int Rb = Epi::PERM ? ((R & ~31) + perm32(R & 31)) : R;
        voffA[i] = (unsigned)(R * g.lda + (g.amode ? ((C >> 4) * (NCH * 256) + (C & 15)) : C)) * 2u; voffB[i] = (unsigned)(Rb * g.ldb + C) * 2u; }
    const size_t kstep = (size_t)(BK * 2); const size_t kA = g.kstepA ? (size_t)g.kstepA : kstep;
    const size_t hA = (size_t)HALF * g.lda * 2, hB = (size_t)HALF * g.ldb * 2;
    const size_t tA = g.tstepA ? (size_t)g.tstepA : 2 * hA, tB = 2 * hB;
    const unsigned ldsw = (unsigned)wid * 1024u;
    const int aoff = lds_byte(wr * 64 + fr, fq * 8), boff = lds_byte(wc * 32 + fr, fq * 8);
#define PG8_SA(b, h) (((b) * 2 + (h)) * HTB)
#define PG8_SB(b, h) ((4 + (b) * 2 + (h)) * HTB)
#define PG8_STAGE(bufoff, gbase, voff) do { _Pragma("unroll") for (int _i = 0; _i < 2; ++_i) \
        __builtin_amdgcn_global_load_lds((const unsigned*)((const char*)(gbase) + (voff)[_i]), (LAS unsigned*)(lds + (bufoff) + ldsw + _i * 8192), 16, 0, 0); } while (0)
#define PG8_LDA(dst, b, h) do { _Pragma("unroll") for (int m = 0; m < 4; ++m) _Pragma("unroll") for (int k = 0; k < 2; ++k) dst[m][k] = *(const LAS bf16x8*)(lds + PG8_SA(b, h) + aoff + m * 2048 + k * 1024); } while (0)
#define PG8_LDB(dst, b, h) do { _Pragma("unroll") for (int n = 0; n < 2; ++n) _Pragma("unroll") for (int k = 0; k < 2; ++k) dst[n][k] = *(const LAS bf16x8*)(lds + PG8_SB(b, h) + boff + n * 2048 + k * 1024); } while (0)
#define PG8_MMA(ai, bj, At, Bt) do { __builtin_amdgcn_s_setprio(1); _Pragma("unroll") for (int m = 0; m < 4; ++m) _Pragma("unroll") for (int n = 0; n < 2; ++n) _Pragma("unroll") for (int k = 0; k < 2; ++k) \
        acc[ai][bj][m][n] = __builtin_amdgcn_mfma_f32_16x16x32_bf16(Bt[n][k], At[m][k], acc[ai][bj][m][n], 0, 0, 0); __builtin_amdgcn_s_setprio(0); } while (0)
#define PG8_WAIT_V(n) asm volatile("s_waitcnt vmcnt(" #n ")" ::: "memory")
#define PG8_WAIT_L(n) asm volatile("s_waitcnt lgkmcnt(" #n ")" ::: "memory")
#define PG8_BAR __builtin_amdgcn_s_barrier()
#define PG8_SCHED __builtin_amdgcn_sched_barrier(0)
    Unit cur, nxt; int ui = 0;
    if (!S.next(0, cur)) return;
    f32x4 acc[2][2][4][2];
#pragma unroll
    for (int a = 0; a < 2; ++a)
#pragma unroll
        for (int b = 0; b < 2; ++b)
#pragma unroll
            for (int m = 0; m < 4; ++m)
#pragma unroll
                for (int n = 0; n < 2; ++n) acc[a][b][m][n] = (f32x4){0.f, 0.f, 0.f, 0.f};
    bf16x8 At[4][2], B0[2][2], B1[2][2];
    const char* cA = (const char*)g.A + (size_t)cur.pm * tA; const char* cB = (const char*)g.Bt + (size_t)cur.pn * tB;
    PG8_STAGE(PG8_SB(0, 0), cB, voffB); PG8_STAGE(PG8_SB(0, 1), cB + hB, voffB); PG8_STAGE(PG8_SA(0, 0), cA, voffA); PG8_STAGE(PG8_SA(0, 1), cA + hA, voffA);
    if (wr == 1) PG8_BAR;
    PG8_WAIT_V(2); PG8_BAR;
    PG8_STAGE(PG8_SB(1, 0), cB + kstep, voffB); PG8_STAGE(PG8_SA(1, 0), cA + kA, voffA); PG8_STAGE(PG8_SB(1, 1), cB + hB + kstep, voffB);
    PG8_WAIT_V(6); PG8_BAR;
    for (;;) {
        const bool has_next = S.next(ui + 1, nxt);
        const char* nA = has_next ? (const char*)g.A + (size_t)nxt.pm * tA : cA; const char* nB = has_next ? (const char*)g.Bt + (size_t)nxt.pn * tB : cB;
        for (int t = 0; t < nt; t += 2) {
            const bool last = (t == nt - 2);
            const char* a1 = cA + (size_t)(t + 1) * kA;
            const char* a2 = last ? nA : cA + (size_t)(t + 2) * kA; const char* b2 = last ? nB : cB + (size_t)(t + 2) * kstep;
            const char* a3 = a2 + kA; const char* b3 = b2 + kstep;
            PG8_LDB(B0, 0, 0); PG8_LDB(B1, 0, 1); PG8_SCHED; PG8_LDA(At, 0, 0); PG8_STAGE(PG8_SA(1, 1), a1 + hA, voffA);
            PG8_WAIT_V(8); PG8_WAIT_L(0); PG8_BAR; PG8_MMA(0, 0, At, B0); PG8_MMA(0, 1, At, B1); PG8_BAR; PG8_SCHED;
            PG8_LDA(At, 0, 1); PG8_STAGE(PG8_SB(0, 0), b2, voffB); PG8_STAGE(PG8_SB(0, 1), b2 + hB, voffB); PG8_STAGE(PG8_SA(0, 0), a2, voffA);
            PG8_WAIT_V(8); PG8_WAIT_L(0); PG8_BAR; PG8_MMA(1, 0, At, B0); PG8_MMA(1, 1, At, B1); PG8_BAR; PG8_SCHED;
            PG8_LDB(B0, 1, 0); PG8_LDB(B1, 1, 1); PG8_SCHED; PG8_LDA(At, 1, 0); PG8_STAGE(PG8_SA(0, 1), a2 + hA, voffA);
            PG8_WAIT_V(8); PG8_WAIT_L(0); PG8_BAR; PG8_MMA(0, 0, At, B0); PG8_MMA(0, 1, At, B1); PG8_BAR; PG8_SCHED;
            PG8_LDA(At, 1, 1); PG8_STAGE(PG8_SB(1, 0), b3, voffB); PG8_STAGE(PG8_SB(1, 1), b3 + hB, voffB); PG8_STAGE(PG8_SA(1, 0), a3, voffA);
            PG8_WAIT_V(8); PG8_WAIT_L(0); PG8_BAR; PG8_MMA(1, 0, At, B0); PG8_MMA(1, 1, At, B1); PG8_BAR; PG8_SCHED;
        }
        if (wr == 0) PG8_BAR;
        E(acc, cur, wr, wc, fr, fq);
        if (!has_next) break;
#pragma unroll
        for (int a = 0; a < 2; ++a)
#pragma unroll
            for (int b = 0; b < 2; ++b)
#pragma unroll
                for (int m = 0; m < 4; ++m)
#pragma unroll
                    for (int n = 0; n < 2; ++n) acc[a][b][m][n] = (f32x4){0.f, 0.f, 0.f, 0.f};
        cur = nxt; cA = nA; cB = nB; ++ui;
        if (wr == 1) PG8_BAR;
    }
    PG8_WAIT_V(0);
    PG8_BAR;
#undef PG8_SA
#undef PG8_SB
#undef PG8_STAGE
#undef PG8_LDA
#undef PG8_LDB
#undef PG8_MMA
#undef PG8_WAIT_V
#undef PG8_WAIT_L
#undef PG8_BAR
#undef PG8_SCHED
}

typedef f32x4 Acc[2][2][4][2];

struct EpiIn {
    static constexpr bool PERM = true;
    bf16_t* A2; bf16_t* UB; bf16_t* VB;
    __device__ __forceinline__ void operator()(const Acc& acc, const Unit& u, int wr, int wc, int fr, int fq) const {
        const int row0 = u.pm * BM + wr * 64 + fr; const int part = u.pn >> 1;
#pragma unroll
        for (int ai = 0; ai < 2; ++ai)
#pragma unroll
            for (int m = 0; m < 4; ++m) { const int row = row0 + ai * HALF + m * 16;
#pragma unroll
                for (int bj = 0; bj < 2; ++bj) { const int col = u.pn * BM + bj * HALF + wc * 32 + 8 * fq;
                    f32x4 v0 = acc[ai][bj][m][0], v1 = acc[ai][bj][m][1]; bf16_t* dst;
                    if (part == 0) { const int g = col >> 4, h0 = col & 15, bc = row >> 4, j = row & 15; dst = A2 + ((size_t)(g * NCH + bc) * 512 + j * 16 + h0); }
                    else { for (int e = 0; e < 4; ++e) { v0[e] = gelu_f(v0[e]); v1[e] = gelu_f(v1[e]); } dst = (part == 1 ? UB : VB) + (size_t)row * 512 + (col - 512 * part); }
                    u32x4 w; w.x = cvt_pk_bf16(v0[0], v0[1]); w.y = cvt_pk_bf16(v0[2], v0[3]); w.z = cvt_pk_bf16(v1[0], v1[1]); w.w = cvt_pk_bf16(v1[2], v1[3]);
                    *(u32x4*)dst = w; } }
    }
};
struct EpiE {
    static constexpr bool PERM = false;
    bf16_t* E;
    __device__ __forceinline__ void operator()(const Acc& acc, const Unit& u, int wr, int wc, int fr, int fq) const {
        const bool odd = fq & 1;
#pragma unroll
        for (int ai = 0; ai < 2; ++ai)
#pragma unroll
            for (int m = 0; m < 4; ++m) { bf16_t* rp = E + (size_t)(u.pm * BM + ai * HALF + wr * 64 + m * 16 + fr) * 256 + wc * 32 + (odd ? 16 + 4 * (fq - 1) : 4 * fq);
#pragma unroll
                for (int bj = 0; bj < 2; ++bj) { const f32x4 v0 = acc[ai][bj][m][0], v1 = acc[ai][bj][m][1];
                    const unsigned a0 = cvt_pk_bf16(v0[0], v0[1]), a1 = cvt_pk_bf16(v0[2], v0[3]), b0 = cvt_pk_bf16(v1[0], v1[1]), b1 = cvt_pk_bf16(v1[2], v1[3]);
                    const unsigned r0 = __shfl_xor(odd ? a0 : b0, 16), r1 = __shfl_xor(odd ? a1 : b1, 16);
                    u32x4 w; if (odd) { w.x = r0; w.y = r1; w.z = b0; w.w = b1; } else { w.x = a0; w.y = a1; w.z = r0; w.w = r1; }
                    *(u32x4*)(rp + bj * HALF) = w; } }
    }
};
struct EpiS3 {
    static constexpr bool PERM = true;
    bf16_t* YG;
    __device__ __forceinline__ void operator()(const Acc& acc, const Unit& u, int wr, int wc, int fr, int fq) const {
        const int g = u.pn;
#pragma unroll
        for (int ai = 0; ai < 2; ++ai)
#pragma unroll
            for (int m = 0; m < 4; ++m) { const int bc = u.pm * BM + ai * HALF + wr * 64 + m * 16 + fr - g * NCH;
#pragma unroll
                for (int bj = 0; bj < 2; ++bj) { const int n0 = bj * HALF + wc * 32 + 8 * fq, i = n0 >> 4, hp = n0 & 15;
                    f32x4 v0 = acc[ai][bj][m][0], v1 = acc[ai][bj][m][1];
                    for (int e = 0; e < 4; ++e) { v0[e] = gelu_f(v0[e]); v1[e] = gelu_f(v1[e]); }
                    u32x4 w; w.x = cvt_pk_bf16(v0[0], v0[1]); w.y = cvt_pk_bf16(v0[2], v0[3]); w.z = cvt_pk_bf16(v1[0], v1[1]); w.w = cvt_pk_bf16(v1[2], v1[3]);
                    *(u32x4*)(YG + (size_t)(g * NCH + bc) * 256 + n0) = w; } }
    }
};
struct EpiGlu {
    static constexpr bool PERM = true;
    const bf16_t* YG; const float* bias; bf16_t* YAB;
    __device__ __forceinline__ void operator()(const Acc& acc, const Unit& u, int wr, int wc, int fr, int fq) const {
        const int row0 = u.pm * BM + wr * 64 + fr;
#pragma unroll
        for (int ai = 0; ai < 2; ++ai)
#pragma unroll
            for (int m = 0; m < 4; ++m) { const int row = row0 + ai * HALF + m * 16;
#pragma unroll
                for (int bj = 0; bj < 2; ++bj) { const int col = u.pn * BM + bj * HALF + wc * 32 + 8 * fq;
                    const u32x4 yv = *(const u32x4*)(YG + (size_t)(col >> 4) * (NCH * 256) + (size_t)row * 16 + (col & 15));
                    const f32x4 b0 = *(const f32x4*)(bias + col), b1 = *(const f32x4*)(bias + col + 4);
                    const f32x4 v0 = acc[ai][bj][m][0] + b0, v1 = acc[ai][bj][m][1] + b1;
                    u32x4 w;
                    w.x = cvt_pk_bf16(bf_lo(yv.x) * sigmoid_f(v0[0]), bf_hi(yv.x) * sigmoid_f(v0[1]));
                    w.y = cvt_pk_bf16(bf_lo(yv.y) * sigmoid_f(v0[2]), bf_hi(yv.y) * sigmoid_f(v0[3]));
                    w.z = cvt_pk_bf16(bf_lo(yv.z) * sigmoid_f(v1[0]), bf_hi(yv.z) * sigmoid_f(v1[1]));
                    w.w = cvt_pk_bf16(bf_lo(yv.w) * sigmoid_f(v1[2]), bf_hi(yv.w) * sigmoid_f(v1[3]));
                    *(u32x4*)(YAB + (size_t)row * 1024 + col) = w; } }
    }
};
template <int MODE> struct EpiRes {
    static constexpr bool PERM = true;
    const float* base0; const float* base1; float* out; bf16_t* XB; float* ssq;
    __device__ __forceinline__ void operator()(const Acc& acc, const Unit& u, int wr, int wc, int fr, int fq) const {
        const int row0 = u.pm * BM + wr * 64 + fr; const int col0 = u.pn * BM + wc * 32 + 8 * fq;
        const float* bp = (MODE == 0) ? ((u.pm < MP / BM) ? base0 : base1) : nullptr;
#pragma unroll
        for (int ai = 0; ai < 2; ++ai) {
            f32x4 bv[4][2][2];
#pragma unroll
            for (int m = 0; m < 4; ++m) { const size_t off = (size_t)(row0 + ai * HALF + m * 16) * DM + col0;
#pragma unroll
                for (int bj = 0; bj < 2; ++bj) {
                    if (MODE == 0) { bv[m][bj][0] = *(const f32x4*)(bp + off + bj * HALF); bv[m][bj][1] = *(const f32x4*)(bp + off + bj * HALF + 4); }
                    else if (MODE == 3) { const u32x4 xv = *(const u32x4*)(XB + off + bj * HALF); const float rn = sqrtf(base1[row0 + ai * HALF + m * 16] * (1.f / DM) + EPS);
                        bv[m][bj][0] = (f32x4){bf_lo(xv.x), bf_hi(xv.x), bf_lo(xv.y), bf_hi(xv.y)} * rn; bv[m][bj][1] = (f32x4){bf_lo(xv.z), bf_hi(xv.z), bf_lo(xv.w), bf_hi(xv.w)} * rn; }
                    else { const u32x4 xv = *(const u32x4*)(XB + off + bj * HALF); bv[m][bj][0] = (f32x4){bf_lo(xv.x), bf_hi(xv.x), bf_lo(xv.y), bf_hi(xv.y)}; bv[m][bj][1] = (f32x4){bf_lo(xv.z), bf_hi(xv.z), bf_lo(xv.w), bf_hi(xv.w)}; } } }
            asm volatile("" ::: "memory");
#pragma unroll
            for (int m = 0; m < 4; ++m) { const int row = row0 + ai * HALF + m * 16; const size_t off = (size_t)row * DM + col0; float sq = 0.f;
#pragma unroll
                for (int bj = 0; bj < 2; ++bj) {
                    const f32x4 o0 = bv[m][bj][0] + acc[ai][bj][m][0], o1 = bv[m][bj][1] + acc[ai][bj][m][1];
                    if (MODE == 2) { *(f32x4*)(out + off + bj * HALF) = o0; *(f32x4*)(out + off + bj * HALF + 4) = o1; }
                    else { sq += ((o0[0] * o0[0] + o0[1] * o0[1]) + (o0[2] * o0[2] + o0[3] * o0[3])) + ((o1[0] * o1[0] + o1[1] * o1[1]) + (o1[2] * o1[2] + o1[3] * o1[3]));
                        u32x4 w; w.x = cvt_pk_bf16(o0[0], o0[1]); w.y = cvt_pk_bf16(o0[2], o0[3]); w.z = cvt_pk_bf16(o1[0], o1[1]); w.w = cvt_pk_bf16(o1[2], o1[3]); *(u32x4*)(XB + off + bj * HALF) = w; } }
                if (MODE != 2) { sq += __shfl_xor(sq, 16); sq += __shfl_xor(sq, 32); if (fq == 0) unsafeAtomicAdd(ssq + row, sq); } }
            asm volatile("" ::: "memory"); }
    }
};
struct EpiSwiglu {
    static constexpr bool PERM = true;
    bf16_t* HB; const float* ssq;
    __device__ __forceinline__ void operator()(const Acc& acc, const Unit& u, int wr, int wc, int fr, int fq) const {
        const int row0 = u.pm * BM + wr * 64 + fr;
#pragma unroll
        for (int ai = 0; ai < 2; ++ai)
#pragma unroll
            for (int m = 0; m < 4; ++m) { const int row = row0 + ai * HALF + m * 16; bf16_t* rp = HB + (size_t)row * DFF + u.pn * HALF + wc * 32 + 8 * fq;
                const float rstd = rsqrtf(ssq[row] * (1.f / DM) + EPS);
                u32x4 w;
#pragma unroll
                for (int bj = 0; bj < 2; ++bj) { const f32x4 gt = acc[ai][bj][m][0] * rstd, up = acc[ai][bj][m][1] * rstd;
                    f32x4 e = gt * (-1.4426950408889634f);
#pragma unroll
                    for (int q = 0; q < 4; ++q) e[q] = __builtin_amdgcn_exp2f(e[q]);
                    e = e + 1.0f;
#pragma unroll
                    for (int q = 0; q < 4; ++q) e[q] = __builtin_amdgcn_rcpf(e[q]);
                    const f32x4 o = gt * e * up;
                    if (bj == 0) { w.x = cvt_pk_bf16(o[0], o[1]); w.y = cvt_pk_bf16(o[2], o[3]); } else { w.z = cvt_pk_bf16(o[0], o[1]); w.w = cvt_pk_bf16(o[2], o[3]); } }
                *(u32x4*)rp = w; }
    }
};
struct EpiBf16 {
    static constexpr bool PERM = true;
    bf16_t* O; int ldc; const float* ssq;
    __device__ __forceinline__ void operator()(const Acc& acc, const Unit& u, int wr, int wc, int fr, int fq) const {
        const int row0 = u.pm * BM + wr * 64 + fr; const int col0 = u.pn * BM + wc * 32 + 8 * fq;
#pragma unroll
        for (int ai = 0; ai < 2; ++ai)
#pragma unroll
            for (int m = 0; m < 4; ++m) { const int row = row0 + ai * HALF + m * 16; bf16_t* rp = O + (size_t)row * ldc + col0;
                const float rstd = rsqrtf(ssq[row] * (1.f / DM) + EPS);
#pragma unroll
                for (int bj = 0; bj < 2; ++bj) { const f32x4 v0 = acc[ai][bj][m][0] * rstd, v1 = acc[ai][bj][m][1] * rstd;
                    u32x4 w; w.x = cvt_pk_bf16(v0[0], v0[1]); w.y = cvt_pk_bf16(v0[2], v0[3]); w.z = cvt_pk_bf16(v1[0], v1[1]); w.w = cvt_pk_bf16(v1[2], v1[3]);
                    *(u32x4*)(rp + bj * HALF) = w; } }
    }
};
}

constexpr int LDS_BYTES = 147456;
struct Args { const float* in[28]; float* out; unsigned char* ws; };

__device__ __forceinline__ float wave_sum(float v) {
#pragma unroll
    for (int o = 1; o < 64; o <<= 1) v += __shfl_xor(v, o);
    return v;
}

__device__ __forceinline__ void transpose_item(const float* W, int K, int N, bf16_t* WT, int mode, float* scr, int item, int lane, const float* ksc = nullptr) {
    const int nblk = N / 32, kb = item / nblk, nb = item % nblk, k0 = 64 * kb, n0 = 32 * nb;
#pragma unroll 8
    for (int i = 0; i < 32; ++i) { const int kk = 2 * i + (lane >> 5); const float sc = ksc ? ksc[k0 + kk] : 1.0f; scr[kk * 33 + (lane & 31)] = W[(size_t)(k0 + kk) * N + n0 + (lane & 31)] * sc; }
    asm volatile("s_waitcnt lgkmcnt(0)" ::: "memory");
    const int c = lane & 7;
#pragma unroll
    for (int j = 0; j < 4; ++j) { const int nl = (lane >> 3) + 8 * j; const float* s = scr + (8 * c) * 33 + nl; const int n = n0 + nl;
        const int row = mode == 0 ? n : (256 * (n >> 7) + 128 * ((n >> 2) & 1) + 32 * ((n >> 5) & 3) + 8 * ((n >> 3) & 3) + (mode == 2 ? 4 : 0) + (n & 3));
        u32x4 o; o.x = cvt_pk_bf16(s[0 * 33], s[1 * 33]); o.y = cvt_pk_bf16(s[2 * 33], s[3 * 33]); o.z = cvt_pk_bf16(s[4 * 33], s[5 * 33]); o.w = cvt_pk_bf16(s[6 * 33], s[7 * 33]);
        *(u32x4*)(WT + (size_t)row * K + k0 + 8 * c) = o; }
    asm volatile("s_waitcnt lgkmcnt(0)" ::: "memory");
}

__device__ __forceinline__ void rms_rows(const float* src0, const float* src1, const float* gw_, bf16_t* XN, float* ssq) {
    if (blockIdx.x < 32) return;
    const int tid = fresh_tid(), lane = tid & 63, gw = (blockIdx.x - 32) * 8 + (tid >> 6), NGW = (gridDim.x - 32) * 8;
    int m = gw; f32x4 v[4];
    if (m < MT) { const f32x4* xr = (const f32x4*)((m < MP) ? src0 + (size_t)m * DM : src1 + (size_t)(m - MP) * DM) + lane;
#pragma unroll
        for (int j = 0; j < 4; ++j) v[j] = __builtin_nontemporal_load(xr + 64 * j); }
    for (; m < MT; m += NGW) {
        const int m2 = m + NGW; f32x4 nv[4];
        if (m2 < MT) { const f32x4* xr = (const f32x4*)((m2 < MP) ? src0 + (size_t)m2 * DM : src1 + (size_t)(m2 - MP) * DM) + lane;
#pragma unroll
            for (int j = 0; j < 4; ++j) nv[j] = __builtin_nontemporal_load(xr + 64 * j); }
        float s = 0.f;
#pragma unroll
        for (int j = 0; j < 4; ++j) s += (v[j].x * v[j].x + v[j].y * v[j].y) + (v[j].z * v[j].z + v[j].w * v[j].w);
        s = wave_sum(s); if (lane == 0) ssq[m] = s;
        const float rstd = rsqrtf(s * (1.f / DM) + EPS);
        u32x2* o8 = (u32x2*)(XN + (size_t)m * DM) + lane;
#pragma unroll
        for (int j = 0; j < 4; ++j) { u32x2 w; w.x = cvt_pk_bf16(v[j].x * rstd, v[j].y * rstd); w.y = cvt_pk_bf16(v[j].z * rstd, v[j].w * rstd); o8[64 * j] = w; }
        if (m2 < MT) {
#pragma unroll
            for (int j = 0; j < 4; ++j) v[j] = nv[j]; }
    }
}

__device__ __forceinline__ void s5_prep(const Args& a, int g, unsigned char* lds) {
    const int tid = fresh_tid();
    f32x2* apow = (f32x2*)lds;
    f32x2* bbar = apow + 2 * 17 * 64;
    f32x2* zt = bbar + 2 * 64 * 16;
    float* kmat = (float*)(zt + 128);
    const float* lam_re = a.in[5]; const float* lam_im = a.in[6]; const float* log_dt = a.in[7];
    const float* b_re = a.in[8]; const float* b_im = a.in[9]; const float* c_re = a.in[10]; const float* c_im = a.in[11]; const float* d_skip = a.in[12];
    bf16_t* B1 = (bf16_t*)(a.ws + WS_B1) + (size_t)g * 256 * 512;
    bf16_t* B3 = (bf16_t*)(a.ws + WS_B3) + (size_t)g * 256 * 512;
    f32x2* AT = (f32x2*)(a.ws + WS_AT);
    if (tid < 128) {
        const int dir = tid >> 6, p = tid & 63; const int idx = (dir * 32 + g) * 64 + p;
        const float lr = lam_re[idx], li = lam_im[idx], dt = expf(log_dt[dir * 32 + g]);
        for (int k = 0; k <= 16; ++k) { const float mg = expf(lr * dt * (float)k), ang = li * dt * (float)k; apow[(dir * 17 + k) * 64 + p] = (f32x2){mg * cosf(ang), mg * sinf(ang)}; }
        const f32x2 a1 = apow[(dir * 17 + 1) * 64 + p]; const float den = lr * lr + li * li;
        zt[dir * 64 + p] = (f32x2){((a1.x - 1.0f) * lr + a1.y * li) / den, (a1.y * lr - (a1.x - 1.0f) * li) / den};
        AT[idx] = apow[(dir * 17 + 16) * 64 + p];
    }
    __syncthreads();
    for (int e = tid; e < 2048; e += 512) { const int dir = e >> 10, p = (e >> 4) & 63, h = e & 15; const size_t gi = ((size_t)(dir * 32 + g) * 64 + p) * 16 + h;
        const float br = b_re[gi], bi = b_im[gi]; const f32x2 z = zt[dir * 64 + p]; bbar[e] = (f32x2){z.x * br - z.y * bi, z.x * bi + z.y * br}; }
    __syncthreads();
    for (int e = tid; e < 31 * 256; e += 512) { const int lag = e / 256 - 15, hp = (e >> 4) & 15, h = e & 15; float sum = 0.f;
        if (lag >= 0) { const size_t ci = ((size_t)(0 * 32 + g) * 16 + hp) * 64;
            for (int p = 0; p < 64; ++p) { const float cr = c_re[ci + p], cim = c_im[ci + p]; const f32x2 aw = apow[(0 * 17 + lag) * 64 + p]; const f32x2 b = bbar[(0 * 64 + p) * 16 + h];
                const float wr_ = cr * aw.x - cim * aw.y, wi_ = cr * aw.y + cim * aw.x; sum += wr_ * b.x - wi_ * b.y; } }
        if (lag <= 0) { const size_t ci = ((size_t)(1 * 32 + g) * 16 + hp) * 64;
            for (int p = 0; p < 64; ++p) { const float cr = c_re[ci + p], cim = c_im[ci + p]; const f32x2 aw = apow[(1 * 17 - lag) * 64 + p]; const f32x2 b = bbar[(1 * 64 + p) * 16 + h];
                const float wr_ = cr * aw.x - cim * aw.y, wi_ = cr * aw.y + cim * aw.x; sum += wr_ * b.x - wi_ * b.y; } }
        if (lag == 0 && hp == h) sum += d_skip[g * 16 + h];
        kmat[e] = sum; }
    __syncthreads();
    for (int e = tid; e < 256 * 256; e += 512) { const int n = e >> 8, k = (e & 255) * 2; const int i = n >> 4, hp = n & 15; float v0, v1;
        if (k < 256) { const int j = k >> 4, h = k & 15; const float* kp = kmat + (i - j + 15) * 256 + hp * 16 + h; v0 = kp[0]; v1 = kp[1]; }
        else { const int kk = k - 256, dir = kk >> 7, p = (kk >> 1) & 63; const int ee = dir == 0 ? i + 1 : 16 - i; const size_t ci = ((size_t)(dir * 32 + g) * 16 + hp) * 64 + p;
            const float cr = c_re[ci], cim = c_im[ci]; const f32x2 aw = apow[(dir * 17 + ee) * 64 + p]; v0 = cr * aw.x - cim * aw.y; v1 = -(cr * aw.y + cim * aw.x); }
        *(unsigned*)(B3 + (size_t)n * 512 + k) = cvt_pk_bf16(v0, v1); }
    for (int e = tid; e < 256 * 128; e += 512) { const int n = e >> 7, k = (e & 127) * 2; const int dir = n >> 7, p = (n >> 1) & 63, ri = n & 1, j = k >> 4, h = k & 15;
        const int ee = dir == 0 ? 15 - j : j; const f32x2 aw = apow[(dir * 17 + ee) * 64 + p]; const f32x2 b0 = bbar[(dir * 64 + p) * 16 + h], b1 = bbar[(dir * 64 + p) * 16 + h + 1];
        const float v0 = ri ? (aw.x * b0.y + aw.y * b0.x) : (aw.x * b0.x - aw.y * b0.y), v1 = ri ? (aw.x * b1.y + aw.y * b1.x) : (aw.x * b1.x - aw.y * b1.y);
        *(unsigned*)(B1 + (size_t)n * 512 + k) = cvt_pk_bf16(v0, v1); }
    __syncthreads();
}

__device__ __forceinline__ void sg_phase(const Args& a, unsigned char* lds) {
    const int tid = fresh_tid();
    bf16_t* VT = (bf16_t*)lds;
    const bf16_t* VB = (const bf16_t*)(a.ws + WS_VB); const bf16_t* UB = (const bf16_t*)(a.ws + WS_UB); bf16_t* YAB = (bf16_t*)(a.ws + WS_R1);
    const int lane = tid & 63, w = tid >> 6, fr = lane & 15, fq = lane >> 4;
    const int G = gridDim.x; int u = blockIdx.x, u_end = 2560, ustep = G;
    if (G == 256) { ustep = 1;
        if (u < 128) { u = u * 9; u_end = u + 9; } else { u = 1152 + (u - 128) * 11; u_end = u + 11; } }
    const int ch = tid & 15, j0 = tid >> 4;
    u32x4 vreg[4];
    if (u < u_end) {
#pragma unroll
        for (int it = 0; it < 4; ++it) vreg[it] = *(const u32x4*)(VB + ((size_t)(u >> 2) * 128 + j0 + 32 * it) * 512 + (u & 3) * 128 + ch * 8); }
    for (; u < u_end; u += ustep) { const int n = u >> 2, h = u & 3;
        const float* gmn = a.in[15] + h * 128; const float* Ws = a.in[16] + (size_t)h * 128 * 128; const float* bs = a.in[17] + h * 128;
        const int i = 16 * w + fr; const size_t tok = (size_t)n * 128 + i;
        u32x4 ub[4];
#pragma unroll
        for (int q = 0; q < 4; ++q) ub[q] = *(const u32x4*)(UB + tok * 512 + h * 128 + 32 * fq + 8 * q);
        f32x4 wv[4][2];
#pragma unroll
        for (int ks = 0; ks < 4; ++ks) { wv[ks][0] = *(const f32x4*)(Ws + (size_t)i * 128 + ks * 32 + fq * 8); wv[ks][1] = *(const f32x4*)(Ws + (size_t)i * 128 + ks * 32 + fq * 8 + 4); }
        const float bsv = bs[i];
        const f32x4 g0 = *(const f32x4*)(gmn + ch * 8), g1 = *(const f32x4*)(gmn + ch * 8 + 4);
        const float gg[8] = {g0.x, g0.y, g0.z, g0.w, g1.x, g1.y, g1.z, g1.w};
#pragma unroll
        for (int it = 0; it < 4; ++it) { const int j = j0 + 32 * it; const u32x4 v = vreg[it];
            float f[8] = {bf_lo(v.x), bf_hi(v.x), bf_lo(v.y), bf_hi(v.y), bf_lo(v.z), bf_hi(v.z), bf_lo(v.w), bf_hi(v.w)};
            float ss = 0.f;
#pragma unroll
            for (int e = 0; e < 8; ++e) ss += f[e] * f[e];
            ss += __shfl_xor(ss, 1); ss += __shfl_xor(ss, 2); ss += __shfl_xor(ss, 4); ss += __shfl_xor(ss, 8);
            const float rstd = rsqrtf(ss * (1.f / 128.f) + EPS);
#pragma unroll
            for (int e = 0; e < 8; e += 2) { const unsigned pk = cvt_pk_bf16(f[e] * rstd * gg[e], f[e + 1] * rstd * gg[e + 1]);
                const int d = ch * 8 + e, r0 = 16 * ((d >> 2) & 7) + 4 * (d >> 5) + (d & 3);
                VT[r0 * 136 + j] = (bf16_t)(pk & 0xffffu); VT[(r0 + 1) * 136 + j] = (bf16_t)(pk >> 16); } }
        __syncthreads();
        if (u + ustep < u_end) { const int u2 = u + ustep;
#pragma unroll
            for (int it = 0; it < 4; ++it) vreg[it] = *(const u32x4*)(VB + ((size_t)(u2 >> 2) * 128 + j0 + 32 * it) * 512 + (u2 & 3) * 128 + ch * 8); }
        bf16x8 bw[4];
#pragma unroll
        for (int ks = 0; ks < 4; ++ks) { const f32x4 w0 = wv[ks][0], w1 = wv[ks][1];
            u32x4 pk; pk.x = cvt_pk_bf16(w0.x, w0.y); pk.y = cvt_pk_bf16(w0.z, w0.w); pk.z = cvt_pk_bf16(w1.x, w1.y); pk.w = cvt_pk_bf16(w1.z, w1.w); bw[ks] = __builtin_bit_cast(bf16x8, pk); }
        f32x4 acc[8];
#pragma unroll
        for (int mt = 0; mt < 8; ++mt) { acc[mt] = (f32x4){0.f, 0.f, 0.f, 0.f};
#pragma unroll
            for (int ks = 0; ks < 4; ++ks) { const bf16x8 av = *(const bf16x8*)(VT + (mt * 16 + fr) * 136 + ks * 32 + fq * 8); acc[mt] = __builtin_amdgcn_mfma_f32_16x16x32_bf16(av, bw[ks], acc[mt], 0, 0, 0); } }
#pragma unroll
        for (int q = 0; q < 4; ++q) { const f32x4 a0 = acc[2 * q] + bsv, a1 = acc[2 * q + 1] + bsv; const u32x4 uv = ub[q]; u32x4 o;
            o.x = cvt_pk_bf16(bf_lo(uv.x) * a0[0], bf_hi(uv.x) * a0[1]); o.y = cvt_pk_bf16(bf_lo(uv.y) * a0[2], bf_hi(uv.y) * a0[3]);
            o.z = cvt_pk_bf16(bf_lo(uv.z) * a1[0], bf_hi(uv.z) * a1[1]); o.w = cvt_pk_bf16(bf_lo(uv.w) * a1[2], bf_hi(uv.w) * a1[3]);
            *(u32x4*)(YAB + tok * 1024 + 512 + h * 128 + 32 * fq + 8 * q) = o; }
        __syncthreads();
    }
}

__device__ __forceinline__ void scan_unit(const Args& a, int unit, int t) {
    const int s = unit >> 5, g = unit & 31; const int nc = s < 4 ? 256 : 512; const int bc0 = s < 4 ? s * 256 : 1024 + (s - 4) * 512;
    const int dir = t >> 6, p = t & 63;
    const f32x2 aT = ((const f32x2*)(a.ws + WS_AT))[(dir * 32 + g) * 64 + p];
    const bf16_t* E = (const bf16_t*)(a.ws + WS_E) + ((size_t)(g * NCH + bc0) * 256 + 2 * t);
    bf16_t* A2 = (bf16_t*)(a.ws + WS_A2) + ((size_t)(g * NCH + bc0) * 512 + 256 + 2 * t);
    float sr = 0.f, si = 0.f;
    for (int c0 = 0; c0 < nc; c0 += 32) {
        unsigned ev[32];
#pragma unroll
        for (int q = 0; q < 32; ++q) { const int c = dir == 0 ? c0 + q : nc - 1 - c0 - q; ev[q] = *(const unsigned*)(E + (size_t)c * 256); }
#pragma unroll
        for (int q = 0; q < 32; ++q) { const int c = dir == 0 ? c0 + q : nc - 1 - c0 - q;
            *(unsigned*)(A2 + (size_t)c * 512) = cvt_pk_bf16(sr, si);
            const float nr = aT.x * sr - aT.y * si + bf_lo(ev[q]), ni = aT.x * si + aT.y * sr + bf_hi(ev[q]); sr = nr; si = ni; }
    }
}

constexpr int KP = 72, VP = 408;
__device__ __forceinline__ void attn_unit(const Args& a, int s, int qb, int kvh, bool cont, unsigned char* lds) {
    const int tid = fresh_tid();
    bf16_t* Kl = (bf16_t*)lds;
    bf16_t* VT = Kl + 400 * KP;
    float* biasL = (float*)(VT + 64 * VP);
    const bf16_t* QKV = (const bf16_t*)(a.ws + WS_R2); bf16_t* O = (bf16_t*)(a.ws + WS_R1);
    const float* qn = a.in[20]; const float* kn = a.in[21]; const float* sinkp = a.in[22]; const float* BIAS = (const float*)(a.ws + WS_BIAS);
    const int L = s < 4 ? 4096 : 8192; const size_t rowbase = s < 4 ? (size_t)s * 4096 : (size_t)MP + (size_t)(s - 4) * 8192;
    const int q0 = qb * 128; const int lane = tid & 63, w = tid >> 6, fr = lane & 15, fq = lane >> 4;
    const bf16_t* qbase = QKV + (rowbase + q0 + (w & 1) * 64 + fr) * 1536 + (kvh * 4 + (w >> 1)) * 64 + fq * 8;
    u32x4 qn0 = *(const u32x4*)qbase, qn1 = *(const u32x4*)(qbase + 32), qn2 = *(const u32x4*)(qbase + 16 * 1536), qn3 = *(const u32x4*)(qbase + 16 * 1536 + 32);
    const int k_lo = cont ? 256 : 0, npieces = (384 - k_lo) * 8;
    u32x4 kvr[6], vvr[6];
#pragma unroll
    for (int it = 0; it < 6; ++it) { const int piece = tid + 512 * it; const int kk = k_lo + (piece >> 3), ch = piece & 7; const int kpos = q0 - 128 + kk; const bool valid = piece < npieces && kpos >= 0 && kpos < L;
        kvr[it] = (u32x4){0u, 0u, 0u, 0u}; vvr[it] = (u32x4){0u, 0u, 0u, 0u};
        if (valid) { const bf16_t* rp = QKV + (rowbase + kpos) * 1536 + kvh * 64 + ch * 8; kvr[it] = *(const u32x4*)(rp + 1024); vvr[it] = *(const u32x4*)(rp + 1280); } }
    const f32x4 g0 = *(const f32x4*)(kn + (tid & 7) * 8), g1 = *(const f32x4*)(kn + (tid & 7) * 8 + 4);
#pragma unroll
    for (int it = 0; it < 6; ++it) { const int piece = tid + 512 * it; const int kk = k_lo + (piece >> 3), ch = piece & 7;
        if (piece < npieces) { const int slot = (q0 + 256 + kk) % 384;
        const u32x4 kv = kvr[it], vv = vvr[it];
        float f[8] = {bf_lo(kv.x), bf_hi(kv.x), bf_lo(kv.y), bf_hi(kv.y), bf_lo(kv.z), bf_hi(kv.z), bf_lo(kv.w), bf_hi(kv.w)};
        float ss = 0.f;
#pragma unroll
        for (int e = 0; e < 8; ++e) ss += f[e] * f[e];
        ss += __shfl_xor(ss, 1); ss += __shfl_xor(ss, 2); ss += __shfl_xor(ss, 4);
        const float rstd = rsqrtf(ss * (1.f / 64.f) + EPS);
        u32x4 o; o.x = cvt_pk_bf16(f[0] * rstd * g0.x, f[1] * rstd * g0.y); o.y = cvt_pk_bf16(f[2] * rstd * g0.z, f[3] * rstd * g0.w);
        o.z = cvt_pk_bf16(f[4] * rstd * g1.x, f[5] * rstd * g1.y); o.w = cvt_pk_bf16(f[6] * rstd * g1.z, f[7] * rstd * g1.w);
        *(u32x4*)(Kl + slot * KP + ch * 8) = o;
        const unsigned vw[4] = {vv.x, vv.y, vv.z, vv.w};
#pragma unroll
        for (int e = 0; e < 4; ++e) { const int d0 = ch * 8 + 2 * e, r0 = ((d0 >> 2) & 3) * 16 + (d0 >> 4) * 4 + (d0 & 3);
            VT[r0 * VP + slot] = (bf16_t)(vw[e] & 0xffffu); VT[(r0 + 1) * VP + slot] = (bf16_t)(vw[e] >> 16); } } }
    if (!cont)
    for (int idx = tid; idx < 4 * 304; idx += 512) { const int hq = idx / 304, ii = idx % 304 - 16; biasL[idx] = (ii >= 0 && ii <= 256) ? BIAS[(kvh * 4 + hq) * 257 + ii] : 0.f; }
    __syncthreads();
    const int hq = w >> 1, H = kvh * 4 + hq; const float sink = sinkp[H] * 1.4426950408889634f; const bool edge = (q0 == 0) || (q0 + 128 == L);
    const float* bl = biasL + hq * 304 + 16;
#define MAKE_QF(R0, R1, QF) { const u32x4 r0 = R0, r1 = R1; \
          float f[16] = {bf_lo(r0.x), bf_hi(r0.x), bf_lo(r0.y), bf_hi(r0.y), bf_lo(r0.z), bf_hi(r0.z), bf_lo(r0.w), bf_hi(r0.w), bf_lo(r1.x), bf_hi(r1.x), bf_lo(r1.y), bf_hi(r1.y), bf_lo(r1.z), bf_hi(r1.z), bf_lo(r1.w), bf_hi(r1.w)}; \
          float ss = 0.f; \
          _Pragma("unroll") for (int e = 0; e < 16; ++e) ss += f[e] * f[e]; \
          ss += __shfl_xor(ss, 16); ss += __shfl_xor(ss, 32); \
          const float rstd = rsqrtf(ss * (1.f / 64.f) + EPS) * (0.125f * 1.4426950408889634f); \
          u32x4 p0, p1; \
          p0.x = cvt_pk_bf16(f[0] * rstd * qg[0].x, f[1] * rstd * qg[0].y); p0.y = cvt_pk_bf16(f[2] * rstd * qg[0].z, f[3] * rstd * qg[0].w); \
          p0.z = cvt_pk_bf16(f[4] * rstd * qg[1].x, f[5] * rstd * qg[1].y); p0.w = cvt_pk_bf16(f[6] * rstd * qg[1].z, f[7] * rstd * qg[1].w); \
          p1.x = cvt_pk_bf16(f[8] * rstd * qg[2].x, f[9] * rstd * qg[2].y); p1.y = cvt_pk_bf16(f[10] * rstd * qg[2].z, f[11] * rstd * qg[2].w); \
          p1.z = cvt_pk_bf16(f[12] * rstd * qg[3].x, f[13] * rstd * qg[3].y); p1.w = cvt_pk_bf16(f[14] * rstd * qg[3].z, f[15] * rstd * qg[3].w); \
          QF[0] = __builtin_bit_cast(bf16x8, p0); QF[1] = __builtin_bit_cast(bf16x8, p1); }
#pragma unroll 1
    for (int pr = 0; pr < 2; ++pr) { const int qs = (w & 1) * 64 + pr * 32;
        bf16x8 qfA[2], qfB[2];
        { f32x4 qg[4];
#pragma unroll
          for (int e = 0; e < 2; ++e) { qg[2 * e] = *(const f32x4*)(qn + e * 32 + fq * 8); qg[2 * e + 1] = *(const f32x4*)(qn + e * 32 + fq * 8 + 4); }
          MAKE_QF(qn0, qn1, qfA) MAKE_QF(qn2, qn3, qfB) }
        f32x4 SA[18], SB[18];
        const int base0 = (q0 + 256 + qs) % 384;
        const LAS unsigned char* kb3 = (const LAS unsigned char*)(Kl + fr * KP + fq * 8); const LAS unsigned char* bb3 = (const LAS unsigned char*)(bl + 4 * fq - fr);
        const LAS unsigned char* vb3 = (const LAS unsigned char*)(VT + fr * VP + 4 * fq);
        {   bf16x8 kf[2][2]; f32x4 bi[2]; f32x4 bprev = {0.f, 0.f, 0.f, 0.f};
#define LDK(buf, kt) { const int sl_ = base0 + 16 * (kt) - ((base0 + 16 * (kt) >= 384) ? 384 : 0); const LAS unsigned char* kp_ = kb3 + sl_ * (KP * 2); \
                _Pragma("unroll") for (int ks = 0; ks < 2; ++ks) kf[buf][ks] = *(const LAS bf16x8*)(kp_ + ks * 64); \
                if ((kt) < 17) { _Pragma("unroll") for (int r = 0; r < 4; ++r) bi[buf][r] = *(const LAS float*)(bb3 + ((kt) * 16 + r) * 4); } }
            LDK(0, 0)
#pragma unroll
            for (int kt = 0; kt < 18; ++kt) {
                if (kt < 17) { LDK((kt + 1) & 1, kt + 1) }
                __builtin_amdgcn_sched_barrier(0);
                if (kt < 17) { f32x4 acc = bi[kt & 1];
                    acc = __builtin_amdgcn_mfma_f32_16x16x32_bf16(kf[kt & 1][0], qfA[0], acc, 0, 0, 0); acc = __builtin_amdgcn_mfma_f32_16x16x32_bf16(kf[kt & 1][1], qfA[1], acc, 0, 0, 0); SA[kt] = acc; }
                if (kt >= 1) { f32x4 acc = bprev;
                    acc = __builtin_amdgcn_mfma_f32_16x16x32_bf16(kf[kt & 1][0], qfB[0], acc, 0, 0, 0); acc = __builtin_amdgcn_mfma_f32_16x16x32_bf16(kf[kt & 1][1], qfB[1], acc, 0, 0, 0); SB[kt] = acc; }
                if (kt < 17) bprev = bi[kt & 1];
                __builtin_amdgcn_sched_barrier(0);
            }
#undef LDK
        }
        u32x2 vf[1][4][2];
#define LDV(buf, kp) { const int cl_ = base0 + 32 * (kp) - ((base0 + 32 * (kp) >= 384) ? 384 : 0); const LAS unsigned char* vp_ = vb3 + cl_ * 2; \
        _Pragma("unroll") for (int dt = 0; dt < 4; ++dt) { vf[buf][dt][0] = *(const LAS u32x2*)(vp_ + (dt * 16 * VP) * 2); vf[buf][dt][1] = *(const LAS u32x2*)(vp_ + (dt * 16 * VP + 16) * 2); } }
#pragma unroll
        for (int r = 0; r < 4; ++r) { if (4 * fq + r - fr < 0) { SA[0][r] = -1e30f; SB[1][r] = -1e30f; } if (4 * fq + r - fr > 0) { SA[16][r] = -1e30f; SB[17][r] = -1e30f; } }
        if (edge) {
#pragma unroll
            for (int kt = 0; kt < 18; ++kt)
#pragma unroll
                for (int r = 0; r < 4; ++r) { const int kpos = q0 - 128 + qs + kt * 16 + 4 * fq + r; if (kpos < 0 || kpos >= L) { if (kt < 17) SA[kt][r] = -1e30f; if (kt >= 1) SB[kt][r] = -1e30f; } } }
        float invA, invB;
        {   float mx = sink;
#pragma unroll
            for (int kt = 0; kt < 17; ++kt)
#pragma unroll
                for (int r = 0; r < 4; ++r) mx = fmaxf(mx, SA[kt][r]);
            mx = fmaxf(mx, __shfl_xor(mx, 16)); mx = fmaxf(mx, __shfl_xor(mx, 32));
            f32x4 sumv = {0.f, 0.f, 0.f, 0.f}; const f32x4 mxv = {mx, mx, mx, mx};
#pragma unroll
            for (int kt = 0; kt < 17; ++kt) { f32x4 d = SA[kt] - mxv;
#pragma unroll
                for (int r = 0; r < 4; ++r) d[r] = __builtin_amdgcn_exp2f(d[r]);
                SA[kt] = d; sumv += d; }
            float sum = (sumv[0] + sumv[1]) + (sumv[2] + sumv[3]);
            sum += __shfl_xor(sum, 16); sum += __shfl_xor(sum, 32); sum += __builtin_amdgcn_exp2f(sink - mx);
            invA = 1.0f / sum; SA[17] = (f32x4){0.f, 0.f, 0.f, 0.f}; }
        {   float mx = sink;
#pragma unroll
            for (int kt = 1; kt < 18; ++kt)
#pragma unroll
                for (int r = 0; r < 4; ++r) mx = fmaxf(mx, SB[kt][r]);
            mx = fmaxf(mx, __shfl_xor(mx, 16)); mx = fmaxf(mx, __shfl_xor(mx, 32));
            f32x4 sumv = {0.f, 0.f, 0.f, 0.f}; const f32x4 mxv = {mx, mx, mx, mx};
#pragma unroll
            for (int kt = 1; kt < 18; ++kt) { f32x4 d = SB[kt] - mxv;
#pragma unroll
                for (int r = 0; r < 4; ++r) d[r] = __builtin_amdgcn_exp2f(d[r]);
                SB[kt] = d; sumv += d; }
            float sum = (sumv[0] + sumv[1]) + (sumv[2] + sumv[3]);
            sum += __shfl_xor(sum, 16); sum += __shfl_xor(sum, 32); sum += __builtin_amdgcn_exp2f(sink - mx);
            invB = 1.0f / sum; SB[0] = (f32x4){0.f, 0.f, 0.f, 0.f}; }
        f32x4 OcA[4], OcB[4];
#pragma unroll
        for (int dt = 0; dt < 4; ++dt) { OcA[dt] = (f32x4){0.f, 0.f, 0.f, 0.f}; OcB[dt] = (f32x4){0.f, 0.f, 0.f, 0.f}; }
#pragma unroll
        for (int kp = 0; kp < 9; ++kp) {
            LDV(0, kp)
            u32x4 pa, pb_;
            pa.x = cvt_pk_bf16(SA[2 * kp][0], SA[2 * kp][1]); pa.y = cvt_pk_bf16(SA[2 * kp][2], SA[2 * kp][3]); pa.z = cvt_pk_bf16(SA[2 * kp + 1][0], SA[2 * kp + 1][1]); pa.w = cvt_pk_bf16(SA[2 * kp + 1][2], SA[2 * kp + 1][3]);
            pb_.x = cvt_pk_bf16(SB[2 * kp][0], SB[2 * kp][1]); pb_.y = cvt_pk_bf16(SB[2 * kp][2], SB[2 * kp][3]); pb_.z = cvt_pk_bf16(SB[2 * kp + 1][0], SB[2 * kp + 1][1]); pb_.w = cvt_pk_bf16(SB[2 * kp + 1][2], SB[2 * kp + 1][3]);
            const bf16x8 pA = __builtin_bit_cast(bf16x8, pa), pB = __builtin_bit_cast(bf16x8, pb_);
#pragma unroll
            for (int dt = 0; dt < 4; ++dt) { u32x4 av; av.x = vf[0][dt][0].x; av.y = vf[0][dt][0].y; av.z = vf[0][dt][1].x; av.w = vf[0][dt][1].y;
                const bf16x8 avf = __builtin_bit_cast(bf16x8, av);
                OcA[dt] = __builtin_amdgcn_mfma_f32_16x16x32_bf16(avf, pA, OcA[dt], 0, 0, 0); OcB[dt] = __builtin_amdgcn_mfma_f32_16x16x32_bf16(avf, pB, OcB[dt], 0, 0, 0); }
            __builtin_amdgcn_sched_barrier(0);
        }
#undef LDV
        { u32x4 o0, o1;
          o0.x = cvt_pk_bf16(OcA[0][0] * invA, OcA[0][1] * invA); o0.y = cvt_pk_bf16(OcA[0][2] * invA, OcA[0][3] * invA); o0.z = cvt_pk_bf16(OcA[1][0] * invA, OcA[1][1] * invA); o0.w = cvt_pk_bf16(OcA[1][2] * invA, OcA[1][3] * invA);
          o1.x = cvt_pk_bf16(OcA[2][0] * invA, OcA[2][1] * invA); o1.y = cvt_pk_bf16(OcA[2][2] * invA, OcA[2][3] * invA); o1.z = cvt_pk_bf16(OcA[3][0] * invA, OcA[3][1] * invA); o1.w = cvt_pk_bf16(OcA[3][2] * invA, OcA[3][3] * invA);
          bf16_t* op = O + (unsigned)(((unsigned)rowbase + q0 + qs + fr) * 1024u + H * 64 + 16 * fq); *(u32x4*)op = o0; *(u32x4*)(op + 8) = o1;
          o0.x = cvt_pk_bf16(OcB[0][0] * invB, OcB[0][1] * invB); o0.y = cvt_pk_bf16(OcB[0][2] * invB, OcB[0][3] * invB); o0.z = cvt_pk_bf16(OcB[1][0] * invB, OcB[1][1] * invB); o0.w = cvt_pk_bf16(OcB[1][2] * invB, OcB[1][3] * invB);
          o1.x = cvt_pk_bf16(OcB[2][0] * invB, OcB[2][1] * invB); o1.y = cvt_pk_bf16(OcB[2][2] * invB, OcB[2][3] * invB); o1.z = cvt_pk_bf16(OcB[3][0] * invB, OcB[3][1] * invB); o1.w = cvt_pk_bf16(OcB[3][2] * invB, OcB[3][3] * invB);
          op += 16 * 1024; *(u32x4*)op = o0; *(u32x4*)(op + 8) = o1; }
        if (pr == 0) { const bf16_t* qb2 = QKV + (unsigned)(((unsigned)rowbase + q0 + (w & 1) * 64 + 32 + fr) * 1536u + (kvh * 4 + (w >> 1)) * 64 + fq * 8);
            qn0 = *(const u32x4*)qb2; qn1 = *(const u32x4*)(qb2 + 32); qn2 = *(const u32x4*)(qb2 + 16 * 1536); qn3 = *(const u32x4*)(qb2 + 16 * 1536 + 32); }
    }
#undef MAKE_QF
    __syncthreads();
}

__device__ __forceinline__ int rel_bucket(int rel) {
    const int n = rel < 0 ? -rel : rel; int ret = rel > 0 ? 16 : 0;
    int large = 8; if (n >= 8) { const unsigned q = (unsigned)(n * n) >> 6; large = 8 + (31 - __builtin_clz(q)); } if (large > 15) large = 15;
    return ret + (n < 8 ? n : large);
}

#define XB_TMO      128
#define XB_XCNT(j)  (256  + 64 * (j))
#define XB_XSUB(j)  (1280 + 64 * (j))
#define XB_XGEN(j)  (2304 + 64 * (j))
#define XB_TOP      3328
#define XB_TOPGEN   3392
#define XCD_BAR_WORDS 3456
#define XB_SPIN_CAP (1u << 22)

__device__ __forceinline__ unsigned xb_ld(unsigned* p)              { return __hip_atomic_load(p, __ATOMIC_RELAXED, __HIP_MEMORY_SCOPE_AGENT); }
__device__ __forceinline__ unsigned xb_add(unsigned* p, unsigned v) { return __hip_atomic_fetch_add(p, v, __ATOMIC_RELAXED, __HIP_MEMORY_SCOPE_AGENT); }
__device__ __forceinline__ unsigned xb_xcc_id() { return (unsigned)__builtin_amdgcn_s_getreg((3 << 11) | 20) & 0xFu; }
#define XB_SPIN(cond, bar) do { unsigned _sp = 0; while (cond) { __builtin_amdgcn_s_sleep(1); \
    if ((++_sp & 255u) == 0u) { if (xb_ld(&(bar)[XB_TMO])) break; if (_sp > XB_SPIN_CAP) { atomicAdd(&(bar)[XB_TMO], 1u); break; } } } } while (0)

struct XcdBarrier {
    unsigned* bar; unsigned x;
    volatile LAS unsigned* st;
};

__device__ __forceinline__ XcdBarrier xcd_barrier_post(unsigned* bar, volatile LAS unsigned* st) {
    XcdBarrier b; b.bar = bar; b.x = xb_xcc_id(); b.st = st;
    if (threadIdx.x == 0) (void)xb_add(&bar[XB_XCNT(b.x)], 1u);
    return b;
}
__device__ __forceinline__ void xcd_barrier_complete(unsigned* bar, unsigned x, unsigned& nloc, unsigned& nx) {
    const unsigned G = gridDim.x * gridDim.y * gridDim.z;
    unsigned sum, cnt, mine, sp = 0u;
    for (;;) {
        sum = 0u; cnt = 0u; mine = 0u;
#pragma unroll
        for (unsigned j = 0; j < 16; ++j) { const unsigned c = xb_ld(&bar[XB_XCNT(j)]); sum += c; cnt += (c > 0u) ? 1u : 0u; mine = (j == x) ? c : mine; }
        if (sum == G) break;
        __builtin_amdgcn_s_sleep(1);
        if ((++sp & 255u) == 0u) { if (xb_ld(&bar[XB_TMO])) break; if (sp > XB_SPIN_CAP) { atomicAdd(&bar[XB_TMO], 1u); break; } }
    }
    nloc = mine > 0u ? mine : 1u; nx = cnt > 0u ? cnt : 1u;
}

__device__ __forceinline__ void xcd_barrier(const XcdBarrier& b) {
    asm volatile("s_waitcnt vmcnt(0)" ::: "memory");
    __syncthreads();
    if (threadIdx.x == 0) {
        unsigned* bar = b.bar;
        __builtin_amdgcn_s_waitcnt(0);
        unsigned nloc = b.st[0], nx = b.st[1];
        if (nloc == 0u) { xcd_barrier_complete(bar, b.x, nloc, nx); b.st[0] = nloc; b.st[1] = nx; }
        const unsigned old = xb_add(&bar[XB_XSUB(b.x)], 1u);
        const unsigned gen = old / nloc;
        if (old + 1u == (gen + 1u) * nloc) {
            __builtin_amdgcn_fence(__ATOMIC_RELEASE, "agent");
            asm volatile("s_waitcnt vmcnt(0)" ::: "memory");
            const unsigned og = xb_add(&bar[XB_TOP], 1u);
            const unsigned tg = og / nx;
            if (og + 1u == (tg + 1u) * nx) xb_add(&bar[XB_TOPGEN], 1u);
            else XB_SPIN(xb_ld(&bar[XB_TOPGEN]) == tg, bar);
            __builtin_amdgcn_fence(__ATOMIC_ACQUIRE, "agent");
            xb_add(&bar[XB_XGEN(b.x)], 1u);
            asm volatile("s_waitcnt vmcnt(0)" ::: "memory");
        } else {
            XB_SPIN(xb_ld(&bar[XB_XGEN(b.x)]) == gen, bar);
            __builtin_amdgcn_fence(__ATOMIC_ACQUIRE, "agent");
            asm volatile("s_waitcnt vmcnt(0)" ::: "memory");
        }
    }
    __syncthreads();
}

__global__ void __launch_bounds__(512, 2) fwd_kernel(Args a) {
    extern __shared__ __attribute__((aligned(16))) unsigned char lds[];
    cg::grid_group grid = cg::this_grid();
    LAS unsigned char* lds3 = (LAS unsigned char*)lds;
    const int G = gridDim.x, bx = blockIdx.x;
    unsigned char* ws = a.ws;
    volatile LAS unsigned* bst = (volatile LAS unsigned*)(lds3 + 131072 + 64);
    { const int t0 = fresh_tid(); if (t0 < 2) bst[t0] = 0u;
      if (bx == 0) for (int e = t0; e < XCD_BAR_WORDS; e += 512) ((unsigned*)(ws + WS_BAR))[e] = 0u; }
    __syncthreads();

    #ifndef NO_S5P
    if (bx < 32) s5_prep(a, bx, lds);
#endif
    {
        const int tid = fresh_tid(), lane = tid & 63, wave = tid >> 6, gw = bx * 8 + wave, NGW = G * 8;
        float* scr = (float*)(lds + wave * 16384);
        constexpr int I_IN = 16 * 48, I_GLU = 8 * 16, I_OUT = 16 * 32, I_QKV = 16 * 48, I_O = 16 * 32, I_G = 16 * 88, I_D = 44 * 32;
        constexpr int NITEMS = I_IN + I_GLU + I_OUT + I_QKV + I_O + 4 * I_G + 2 * I_D;
        for (int it = gw; it < NITEMS; it += NGW) {
            int r = it;
            if (r < I_IN) { transpose_item(a.in[4], 1024, 1536, (bf16_t*)(ws + WS_WIN), 0, scr, r, lane, a.in[2]); continue; } r -= I_IN;
            if (r < I_GLU) { transpose_item(a.in[13], 512, 512, (bf16_t*)(ws + WS_WGLU), 0, scr, r, lane); continue; } r -= I_GLU;
            if (r < I_OUT) { transpose_item(a.in[18], 1024, 1024, (bf16_t*)(ws + WS_WOUT), 0, scr, r, lane); continue; } r -= I_OUT;
            if (r < I_QKV) { transpose_item(a.in[19], 1024, 1536, (bf16_t*)(ws + WS_WQKV), 0, scr, r, lane, a.in[2] + DM); continue; } r -= I_QKV;
            if (r < I_O) { transpose_item(a.in[23], 1024, 1024, (bf16_t*)(ws + WS_WO), 0, scr, r, lane); continue; } r -= I_O;
            if (r < 4 * I_G) { const int l = r / (2 * I_G), rr = r % (2 * I_G), up = rr / I_G, item = rr % I_G;
                transpose_item(a.in[up ? 26 : 25] + (size_t)l * 1024 * DFF, 1024, DFF, (bf16_t*)(ws + (l ? WS_WGU1 : WS_WGU0)), up ? 2 : 1, scr, item, lane, a.in[3] + l * DM); continue; } r -= 4 * I_G;
            { const int l = r / I_D, item = r % I_D; transpose_item(a.in[27] + (size_t)l * DFF * 1024, DFF, 1024, (bf16_t*)(ws + (l ? WS_WD1 : WS_WD0)), 0, scr, item, lane); }
        }
        for (int e = bx * 512 + tid; e < 16 * 257; e += G * 512) { const int h = e / 257, rel = e % 257 - 128; ((float*)(ws + WS_BIAS))[e] = a.in[24][rel_bucket(rel) * 16 + h] * 1.4426950408889634f; }
        for (int e = bx * 512 + tid; e < 3 * MT; e += G * 512) ((float*)(ws + WS_SSQ))[e] = 0.f;
        rms_rows(a.in[0], a.in[1], a.in[2], (bf16_t*)(ws + WS_XB), (float*)(ws + WS_SSQ) + 3 * MT);
    }
    grid.sync();
    const XcdBarrier xbar = xcd_barrier_post((unsigned*)(ws + WS_BAR), bst);

    { constexpr int layer = 0;
        if constexpr (layer == 0) {
            { pg8::Gemm g{(const bf16_t*)(ws + WS_XB), (const bf16_t*)(ws + WS_WIN), 1024, 1024, 1024, 0, 0, 0}; pg8::StaticOrder S; S.init(MT, 1536, G, bx);
              pg8::EpiIn E{(bf16_t*)(ws + WS_A2), (bf16_t*)(ws + WS_UB), (bf16_t*)(ws + WS_VB)};
              pg8::gemm_phase(lds3, g, S, E); }
            xcd_barrier(xbar);
            { pg8::Gemm g{(const bf16_t*)(ws + WS_A2), (const bf16_t*)(ws + WS_B1), 256, 512, 512, 0, 0, 0}; pg8::GroupedOrder S{G, bx};
              pg8::EpiE E{(bf16_t*)(ws + WS_E)};
              pg8::gemm_phase(lds3, g, S, E); }
            __syncthreads();
#ifndef NO_SG
            sg_phase(a, lds);
#endif
            xcd_barrier(xbar);
            { const int tid_ = fresh_tid(); const int sub = tid_ >> 7, t = tid_ & 127; const int unit = sub * G + bx;
#ifndef NO_SCAN
              if (unit < 384) scan_unit(a, unit, t);
#endif
            }
            xcd_barrier(xbar);
            { pg8::Gemm g{(const bf16_t*)(ws + WS_A2), (const bf16_t*)(ws + WS_B3), 512, 512, 512, 0, 0, 0}; pg8::GroupedOrder S{G, bx};
              pg8::EpiS3 E{(bf16_t*)(ws + WS_YG)};
              pg8::gemm_phase(lds3, g, S, E); }
            xcd_barrier(xbar);
            { pg8::Gemm g{(const bf16_t*)(ws + WS_YG), (const bf16_t*)(ws + WS_WGLU), 512, 16, 512, 4u * NCH * 256u * 2u, 256u * 16u * 2u, 1}; pg8::StaticOrder S; S.init(MT, 512, G, bx);
              pg8::EpiGlu E{(const bf16_t*)(ws + WS_YG), a.in[14], (bf16_t*)(ws + WS_R1)};
              pg8::gemm_phase(lds3, g, S, E); }
            xcd_barrier(xbar);
        } else {
            { pg8::Gemm g{(const bf16_t*)(ws + WS_XB), (const bf16_t*)(ws + WS_WQKV), 1024, 1024, 1024, 0, 0, 0}; pg8::StaticOrder S; S.init(MT, 1536, G, bx);
              pg8::EpiBf16 E{(bf16_t*)(ws + WS_R2), 1536, (const float*)(ws + WS_SSQ) + MT};
              pg8::gemm_phase(lds3, g, S, E); }
            xcd_barrier(xbar);
            { const int u_lo = (int)((long)bx * 2560 / G), u_hi = (int)((long)(bx + 1) * 2560 / G); int pst = -1, pqb = -2;
              for (int U = u_lo; U < u_hi; ++U) { int st, qb; if (U < 512) { st = U >> 5; qb = U & 31; } else { st = 16 + ((U - 512) >> 6); qb = (U - 512) & 63; }
                const int s = st >> 2, kvh = st & 3; const bool cont = (st == pst) && (qb == pqb + 1); pst = st; pqb = qb;
                attn_unit(a, s, qb, kvh, cont, lds); } }
            xcd_barrier(xbar);
        }
        { pg8::Gemm g{(const bf16_t*)(ws + WS_R1), (const bf16_t*)(ws + (layer ? WS_WO : WS_WOUT)), 1024, 1024, 1024, 0, 0, 0}; pg8::StaticOrder S; S.init(MT, 1024, G, bx);
          if constexpr (layer == 0) { pg8::EpiRes<3> E{a.in[2], (const float*)(ws + WS_SSQ) + 3 * MT, nullptr, (bf16_t*)(ws + WS_XB), (float*)(ws + WS_SSQ)}; pg8::gemm_phase(lds3, g, S, E); }
          else { pg8::EpiRes<1> E{nullptr, nullptr, nullptr, (bf16_t*)(ws + WS_XB), (float*)(ws + WS_SSQ) + 2 * MT}; pg8::gemm_phase(lds3, g, S, E); } }
        xcd_barrier(xbar);
        { pg8::Gemm g{(const bf16_t*)(ws + WS_XB), (const bf16_t*)(ws + (layer ? WS_WGU1 : WS_WGU0)), 1024, 1024, 1024, 0, 0, 0}; pg8::StaticOrder S; S.init(MT, NGU, G, bx);
          pg8::EpiSwiglu E{(bf16_t*)(ws + WS_R2), (const float*)(ws + WS_SSQ) + (layer ? 2 * MT : 0)};
          pg8::gemm_phase(lds3, g, S, E); }
        xcd_barrier(xbar);
        { pg8::Gemm g{(const bf16_t*)(ws + WS_R2), (const bf16_t*)(ws + (layer ? WS_WD1 : WS_WD0)), DFF, DFF, DFF, 0, 0, 0}; pg8::StaticOrder S; S.init(MT, 1024, G, bx, true);
          if constexpr (layer == 0) { pg8::EpiRes<1> E{nullptr, nullptr, nullptr, (bf16_t*)(ws + WS_XB), (float*)(ws + WS_SSQ) + MT}; pg8::gemm_phase(lds3, g, S, E); xcd_barrier(xbar); }
          else { pg8::EpiRes<2> E{nullptr, nullptr, a.out, (bf16_t*)(ws + WS_XB), nullptr}; pg8::gemm_phase(lds3, g, S, E); } }
    }
    { constexpr int layer = 1;
        if constexpr (layer == 0) {
            { pg8::Gemm g{(const bf16_t*)(ws + WS_XB), (const bf16_t*)(ws + WS_WIN), 1024, 1024, 1024, 0, 0, 0}; pg8::StaticOrder S; S.init(MT, 1536, G, bx);
              pg8::EpiIn E{(bf16_t*)(ws + WS_A2), (bf16_t*)(ws + WS_UB), (bf16_t*)(ws + WS_VB)};
              pg8::gemm_phase(lds3, g, S, E); }
            xcd_barrier(xbar);
            { pg8::Gemm g{(const bf16_t*)(ws + WS_A2), (const bf16_t*)(ws + WS_B1), 256, 512, 512, 0, 0, 0}; pg8::GroupedOrder S{G, bx};
              pg8::EpiE E{(bf16_t*)(ws + WS_E)};
              pg8::gemm_phase(lds3, g, S, E); }
            __syncthreads();
#ifndef NO_SG
            sg_phase(a, lds);
#endif
            xcd_barrier(xbar);
            { const int tid_ = fresh_tid(); const int sub = tid_ >> 7, t = tid_ & 127; const int unit = sub * G + bx;
#ifndef NO_SCAN
              if (unit < 384) scan_unit(a, unit, t);
#endif
            }
            xcd_barrier(xbar);
            { pg8::Gemm g{(const bf16_t*)(ws + WS_A2), (const bf16_t*)(ws + WS_B3), 512, 512, 512, 0, 0, 0}; pg8::GroupedOrder S{G, bx};
              pg8::EpiS3 E{(bf16_t*)(ws + WS_YG)};
              pg8::gemm_phase(lds3, g, S, E); }
            xcd_barrier(xbar);
            { pg8::Gemm g{(const bf16_t*)(ws + WS_YG), (const bf16_t*)(ws + WS_WGLU), 512, 16, 512, 4u * NCH * 256u * 2u, 256u * 16u * 2u, 1}; pg8::StaticOrder S; S.init(MT, 512, G, bx);
              pg8::EpiGlu E{(const bf16_t*)(ws + WS_YG), a.in[14], (bf16_t*)(ws + WS_R1)};
              pg8::gemm_phase(lds3, g, S, E); }
            xcd_barrier(xbar);
        } else {
            { pg8::Gemm g{(const bf16_t*)(ws + WS_XB), (const bf16_t*)(ws + WS_WQKV), 1024, 1024, 1024, 0, 0, 0}; pg8::StaticOrder S; S.init(MT, 1536, G, bx);
              pg8::EpiBf16 E{(bf16_t*)(ws + WS_R2), 1536, (const float*)(ws + WS_SSQ) + MT};
              pg8::gemm_phase(lds3, g, S, E); }
            xcd_barrier(xbar);
            { const int u_lo = (int)((long)bx * 2560 / G), u_hi = (int)((long)(bx + 1) * 2560 / G); int pst = -1, pqb = -2;
              for (int U = u_lo; U < u_hi; ++U) { int st, qb; if (U < 512) { st = U >> 5; qb = U & 31; } else { st = 16 + ((U - 512) >> 6); qb = (U - 512) & 63; }
                const int s = st >> 2, kvh = st & 3; const bool cont = (st == pst) && (qb == pqb + 1); pst = st; pqb = qb;
                attn_unit(a, s, qb, kvh, cont, lds); } }
            xcd_barrier(xbar);
        }
        { pg8::Gemm g{(const bf16_t*)(ws + WS_R1), (const bf16_t*)(ws + (layer ? WS_WO : WS_WOUT)), 1024, 1024, 1024, 0, 0, 0}; pg8::StaticOrder S; S.init(MT, 1024, G, bx);
          if constexpr (layer == 0) { pg8::EpiRes<3> E{a.in[2], (const float*)(ws + WS_SSQ) + 3 * MT, nullptr, (bf16_t*)(ws + WS_XB), (float*)(ws + WS_SSQ)}; pg8::gemm_phase(lds3, g, S, E); }
          else { pg8::EpiRes<1> E{nullptr, nullptr, nullptr, (bf16_t*)(ws + WS_XB), (float*)(ws + WS_SSQ) + 2 * MT}; pg8::gemm_phase(lds3, g, S, E); } }
        xcd_barrier(xbar);
        { pg8::Gemm g{(const bf16_t*)(ws + WS_XB), (const bf16_t*)(ws + (layer ? WS_WGU1 : WS_WGU0)), 1024, 1024, 1024, 0, 0, 0}; pg8::StaticOrder S; S.init(MT, NGU, G, bx);
          pg8::EpiSwiglu E{(bf16_t*)(ws + WS_R2), (const float*)(ws + WS_SSQ) + (layer ? 2 * MT : 0)};
          pg8::gemm_phase(lds3, g, S, E); }
        xcd_barrier(xbar);
        { pg8::Gemm g{(const bf16_t*)(ws + WS_R2), (const bf16_t*)(ws + (layer ? WS_WD1 : WS_WD0)), DFF, DFF, DFF, 0, 0, 0}; pg8::StaticOrder S; S.init(MT, 1024, G, bx, true);
          if constexpr (layer == 0) { pg8::EpiRes<1> E{nullptr, nullptr, nullptr, (bf16_t*)(ws + WS_XB), (float*)(ws + WS_SSQ) + MT}; pg8::gemm_phase(lds3, g, S, E); xcd_barrier(xbar); }
          else { pg8::EpiRes<2> E{nullptr, nullptr, a.out, (bf16_t*)(ws + WS_XB), nullptr}; pg8::gemm_phase(lds3, g, S, E); } }
    }
}

extern "C" void kernel_launch(void* const* d_in, const int* in_sizes, int n_in, void* d_out, int out_size, void* d_ws, size_t ws_size, hipStream_t stream) {
    static int grid = 0;
    if (grid == 0) {
        if (n_in != 28 || out_size != MT * DM || ws_size < WS_END) { fprintf(stderr, "kernel_launch: unexpected shapes (n_in %d out %d ws %zu)\n", n_in, out_size, ws_size); grid = -1; return; }
        int dev = 0, cus = 0, per_cu = 0;
        hipGetDevice(&dev); hipDeviceGetAttribute(&cus, hipDeviceAttributeMultiprocessorCount, dev);
        hipFuncSetAttribute((const void*)fwd_kernel, hipFuncAttributeMaxDynamicSharedMemorySize, LDS_BYTES);
        hipOccupancyMaxActiveBlocksPerMultiprocessor(&per_cu, (const void*)fwd_kernel, 512, LDS_BYTES);
        if (per_cu < 1) per_cu = 1;
        grid = cus * per_cu;
        (void)hipGetLastError();
    }
    if (grid < 0) return;
    Args a{};
    for (int i = 0; i < 28; ++i) a.in[i] = (const float*)d_in[i];
    a.out = (float*)d_out; a.ws = (unsigned char*)d_ws;
    void* args[] = {&a};
    hipError_t e = hipLaunchCooperativeKernel((const void*)fwd_kernel, dim3(grid), dim3(512), args, LDS_BYTES, stream);
    if (e != hipSuccess) fprintf(stderr, "cooperative launch failed: %s (grid %d)\n", hipGetErrorString(e), grid);
}
```
